# Optimizing an MI355X kernel written in HIP

```python
import math
import jax
import jax.numpy as jnp
from jax import lax
import numpy as np

D_MODEL = 1024
BATCH = 32
SEQ = 2048
DEPTH = 1

CTX_LEN = 256
GRID_W = 64
MIX_W = D_MODEL
HY_W = MIX_W // 2
HG_W = MIX_W - HY_W
HY_ORDER = 2
HY_EMB = 33
HY_BANDS = (HY_EMB - 1) // 2
HY_FILTER_HIDDEN = 64
HY_DECAY_TARGET = 1e-2
HY_FAST_DECAY_PCT = 0.3
HY_SLOW_DECAY_PCT = 1.5
HG_HEAD_DIM = 128
HG_HEADS = HG_W // HG_HEAD_DIM
HG_SCALE = HG_HEAD_DIM ** -0.5
HG_CHUNK = 64
N_EXPERTS = 256
TOP_K = 8
N_GROUPS = 8
TOPK_GROUPS = 4
EXPERT_FF = 256
SHARED_FF = 256
ROUTED_SCALE = 2.5
MOE_BLOCK = 128
NORM_EPS = 1e-6
IN_COLS = 3 * HY_W + 5 * HG_W

kernel_name = 'hyena_hgrn2_moe_diffusion_block'


def rmsnorm(x, g):
    xf = x.astype(jnp.float32)
    y = xf * lax.rsqrt(jnp.mean(xf * xf, axis=-1, keepdims=True) + NORM_EPS)
    return (y * g.astype(jnp.float32)).astype(x.dtype)


def centred_conv3(u, w, b):
    pad = [(0, 0)] * (u.ndim - 2) + [(1, 1), (0, 0)]
    up = jnp.pad(u, pad)
    return w[0] * up[..., :-2, :] + w[1] * up[..., 1:-1, :] + w[2] * up[..., 2:, :] + b


def hyena_filter_spectrum(L, fw1, fb1, fw2, fb2, fw3, freq):
    f32 = jnp.float32
    pos = jnp.arange(L, dtype=f32)[:, None]
    t = pos / max(L - 1, 1)
    w = (2.0 * math.pi / L) * pos
    bands = jnp.linspace(1e-4, HY_BANDS - 1, HY_BANDS, dtype=f32)[None, :]
    feats = jnp.concatenate([t, jnp.cos(bands * w), -jnp.sin(bands * w)], axis=-1)
    fr = freq.astype(f32)
    h = jnp.sin(fr * (feats @ fw1.astype(f32) + fb1.astype(f32)))
    h = jnp.sin(fr * (h @ fw2.astype(f32) + fb2.astype(f32)))
    h = (h @ fw3.astype(f32)).reshape(L, HY_ORDER, 2, HY_W)
    max_decay = math.log(HY_DECAY_TARGET) / HY_FAST_DECAY_PCT
    min_decay = math.log(HY_DECAY_TARGET) / HY_SLOW_DECAY_PCT
    deltas = jnp.abs(jnp.linspace(min_decay, max_decay, HY_W, dtype=f32))
    h = h * jnp.exp(-t * deltas)[:, None, None, :]
    h = h / jnp.sum(jnp.abs(h), axis=(0, 2), keepdims=True)
    fwd, bwd = h[:, :, 0], h[:, :, 1]
    k_circ = jnp.concatenate([fwd[:1] + bwd[:1], fwd[1:], jnp.zeros_like(fwd[:1]), bwd[1:][::-1]], axis=0)
    return jnp.fft.rfft(k_circ, axis=0)


def hyena_group(p, rows, conv_w, conv_b, fw1, fb1, fw2, fb2, fw3, freq, d_skip):
    B, L, C3 = p.shape
    u = p.astype(jnp.float32)
    cw, cb = conv_w.astype(jnp.float32), conv_b.astype(jnp.float32)
    if rows is None:
        u = centred_conv3(u, cw, cb)
    else:
        u = centred_conv3(u.reshape(B, rows, GRID_W, C3), cw, cb).reshape(B, L, C3)
    x1, x2, v = jnp.split(u, 3, axis=-1)
    k_hat = hyena_filter_spectrum(L, fw1, fb1, fw2, fb2, fw3, freq)
    ds = d_skip.astype(jnp.float32)

    def long_conv(z, o):
        z_hat = jnp.fft.rfft(z, n=2 * L, axis=1)
        y = jnp.fft.irfft(z_hat * k_hat[:, o], n=2 * L, axis=1)[:, :L]
        return y + z * ds[o]

    z = x1 * long_conv(v, 0)
    y = x2 * long_conv(z, 1)
    return y.astype(p.dtype)


def gla_chunk(q, k, v, log_f, s0):
    B, H, L, DK = q.shape
    DV = v.shape[-1]
    N = L // HG_CHUNK
    q, k, log_f = (a.reshape(B, H, N, HG_CHUNK, DK) for a in (q, k, log_f))
    v = v.reshape(B, H, N, HG_CHUNK, DV)
    b = jnp.cumsum(log_f, axis=3)
    b_last = b[:, :, :, -1:, :]
    b_mid = b[:, :, :, HG_CHUNK // 2 - 1:HG_CHUNK // 2, :]
    qm = q * jnp.exp(b - b_mid)
    km = k * jnp.exp(b_mid - b)
    mask = jnp.tril(jnp.ones((HG_CHUNK, HG_CHUNK), dtype=bool))
    att = jnp.where(mask, jnp.einsum('bhncd,bhnsd->bhncs', qm, km), 0.0)
    o_intra = jnp.einsum('bhncs,bhnsv->bhncv', att, v)
    u = jnp.einsum('bhnsd,bhnsv->bhndv', k * jnp.exp(b_last - b), v)
    decay = jnp.exp(b_last[:, :, :, 0, :])

    def step(s, inp):
        dec, un = inp
        return dec[..., None] * s + un, s

    s_final, s_prev = lax.scan(step, s0, (jnp.moveaxis(decay, 2, 0), jnp.moveaxis(u, 2, 0)))
    s_prev = jnp.moveaxis(s_prev, 0, 2)
    o_inter = jnp.einsum('bhncd,bhndv->bhncv', q * jnp.exp(b), s_prev)
    return (o_intra + o_inter).reshape(B, H, L, DV), s_final


def hgrn2_group(p, lb_f, lb_b, norm_g, s0_f, s0_b):
    B, L, _ = p.shape
    pf = p.astype(jnp.float32)
    q, f_fwd, f_bwd, i, g = jnp.split(pf, 5, axis=-1)
    heads = lambda a: a.reshape(B, L, HG_HEADS, HG_HEAD_DIM).transpose(0, 2, 1, 3)
    q = heads(jax.nn.silu(q) * HG_SCALE)
    v = heads(i)

    def forget(fr, lb):
        lb = lb.astype(jnp.float32)
        log_f = jnp.log(lb + (1.0 - lb) * jax.nn.sigmoid(fr))
        k = (1.0 - lb) * jax.nn.sigmoid(-fr)
        return heads(log_f), heads(k)

    lf_f, k_f = forget(f_fwd, lb_f)
    lf_b, k_b = forget(f_bwd, lb_b)
    o_f, s_f = gla_chunk(q, k_f, v, lf_f, s0_f)
    rev = lambda a: jnp.flip(a, axis=2)
    o_b, s_b = gla_chunk(rev(q), rev(k_b), rev(v), rev(lf_b), s0_b)
    o = o_f + rev(o_b)
    o = o * lax.rsqrt(jnp.mean(o * o, axis=-1, keepdims=True) + NORM_EPS) * norm_g.astype(jnp.float32)
    o = o.transpose(0, 2, 1, 3).reshape(B, L, HG_W) * jax.nn.silu(g)
    return o.astype(p.dtype), s_f, s_b


def moe_ffn(h, w_router, router_bias, ew_gate, ew_up, ew_down, sw_gate, sw_up, sw_down):
    T, D = h.shape
    f32 = jnp.float32
    scores = jax.nn.sigmoid(h.astype(f32) @ w_router.astype(f32))
    biased = scores + router_bias.astype(f32)
    grp = biased.reshape(T, N_GROUPS, N_EXPERTS // N_GROUPS)
    grp_score = jnp.sum(lax.top_k(grp, 2)[0], axis=-1)
    _, top_grp = lax.top_k(grp_score, TOPK_GROUPS)
    grp_mask = jnp.sum(jax.nn.one_hot(top_grp, N_GROUPS, dtype=f32), axis=1) > 0
    expert_mask = jnp.repeat(grp_mask, N_EXPERTS // N_GROUPS, axis=1)
    _, top_e = lax.top_k(jnp.where(expert_mask, biased, -jnp.inf), TOP_K)
    w = jnp.take_along_axis(scores, top_e, axis=1)
    w = ROUTED_SCALE * w / jnp.sum(w, axis=-1, keepdims=True)
    n_assign = T * TOP_K
    flat_e = top_e.reshape(n_assign)
    flat_tok = jnp.repeat(jnp.arange(T, dtype=jnp.int32), TOP_K)
    order = jnp.argsort(flat_e)
    e_sorted = flat_e[order]
    counts = jnp.bincount(flat_e, length=N_EXPERTS)
    starts = jnp.cumsum(counts) - counts
    padded = (counts + MOE_BLOCK - 1) // MOE_BLOCK * MOE_BLOCK
    p_ends = jnp.cumsum(padded)
    p_starts = p_ends - padded
    dest = p_starts[e_sorted] + (jnp.arange(n_assign, dtype=jnp.int32) - starts[e_sorted])
    n_blocks = -(-n_assign // MOE_BLOCK) + N_EXPERTS
    slot_tok = jnp.full((n_blocks * MOE_BLOCK,), T, jnp.int32).at[dest].set(flat_tok[order])
    slot_w = jnp.zeros((n_blocks * MOE_BLOCK,), h.dtype).at[dest].set(w.reshape(n_assign)[order].astype(h.dtype))
    block_e = jnp.minimum(jnp.searchsorted(p_ends, jnp.arange(n_blocks, dtype=jnp.int32) * MOE_BLOCK, side='right'), N_EXPERTS - 1)
    h_pad = jnp.concatenate([h, jnp.zeros((1, D), h.dtype)], axis=0)

    def expert_block(acc, blk):
        tok, wt, e = blk
        xb = h_pad[tok]
        yb = (jax.nn.silu(xb @ ew_gate[e]) * (xb @ ew_up[e])) @ ew_down[e]
        return acc.at[tok].add(yb * wt[:, None]), None

    acc, _ = lax.scan(expert_block, jnp.zeros_like(h_pad),
                      (slot_tok.reshape(n_blocks, MOE_BLOCK), slot_w.reshape(n_blocks, MOE_BLOCK), block_e))
    shared = (jax.nn.silu(h @ sw_gate) * (h @ sw_up)) @ sw_down
    return acc[:T] + shared


def setup_inputs(seed: int = 0) -> dict:
    key = jax.random.key(seed)
    ks = jax.random.split(key, 30)
    nrm = lambda i, shape, scale: scale * jax.random.normal(ks[i], shape, jnp.float32)
    D, L_ = D_MODEL, DEPTH
    return {
        'x': nrm(0, (BATCH, SEQ, D), 1.0),
        'c': nrm(1, (BATCH, D), 1.0),
        'ctx': nrm(2, (BATCH, CTX_LEN, D), 1.0),
        'c_ctx': nrm(3, (D,), 1.0),
        'w_mod': nrm(4, (L_, D, 6 * D), 0.5 * D ** -0.5),
        'b_mod': nrm(5, (L_, 6 * D), 0.02),
        'norm1_g': 1.0 + nrm(6, (L_, D), 0.05),
        'norm2_g': 1.0 + nrm(7, (L_, D), 0.05),
        'w_in': nrm(8, (L_, D, IN_COLS), D ** -0.5),
        'w_out': nrm(9, (L_, MIX_W, D), MIX_W ** -0.5),
        'hy_conv_w': nrm(10, (L_, 3, 3 * HY_W), 0.5),
        'hy_conv_b': nrm(11, (L_, 3 * HY_W), 0.02),
        'hy_fw1': nrm(12, (L_, HY_EMB, HY_FILTER_HIDDEN), HY_EMB ** -0.5),
        'hy_fb1': nrm(13, (L_, HY_FILTER_HIDDEN), 0.1),
        'hy_fw2': nrm(14, (L_, HY_FILTER_HIDDEN, HY_FILTER_HIDDEN), HY_FILTER_HIDDEN ** -0.5),
        'hy_fb2': nrm(15, (L_, HY_FILTER_HIDDEN), 0.1),
        'hy_fw3': nrm(16, (L_, HY_FILTER_HIDDEN, HY_ORDER * 2 * HY_W), HY_FILTER_HIDDEN ** -0.5),
        'hy_freq': 1.0 + nrm(17, (L_, HY_FILTER_HIDDEN), 0.1),
        'hy_d': nrm(18, (L_, HY_ORDER, HY_W), 0.5),
        'hg_lb_logits': nrm(19, (2, L_ + 1, HG_W), 0.1),
        'hg_norm_g': 1.0 + nrm(20, (L_, HG_HEAD_DIM), 0.05),
        'w_router': nrm(21, (L_, D, N_EXPERTS), D ** -0.5),
        'router_bias': nrm(22, (L_, N_EXPERTS), 0.01),
        'ew_gate': nrm(23, (L_, N_EXPERTS, D, EXPERT_FF), D ** -0.5),
        'ew_up': nrm(24, (L_, N_EXPERTS, D, EXPERT_FF), D ** -0.5),
        'ew_down': nrm(25, (L_, N_EXPERTS, EXPERT_FF, D), EXPERT_FF ** -0.5),
        'sw_gate': nrm(26, (L_, D, SHARED_FF), D ** -0.5),
        'sw_up': nrm(27, (L_, D, SHARED_FF), D ** -0.5),
        'sw_down': nrm(28, (L_, SHARED_FF, D), SHARED_FF ** -0.5),
        'final_g': 1.0 + nrm(29, (D,), 0.05),
    }


def reference(x, c, ctx, c_ctx, w_mod, b_mod, norm1_g, norm2_g, w_in, w_out, hy_conv_w, hy_conv_b,
              hy_fw1, hy_fb1, hy_fw2, hy_fb2, hy_fw3, hy_freq, hy_d, hg_lb_logits, hg_norm_g,
              w_router, router_bias, ew_gate, ew_up, ew_down, sw_gate, sw_up, sw_down, final_g):
    B, L, D = x.shape
    rows = L // GRID_W
    lower_bounds = jnp.cumsum(jax.nn.softmax(hg_lb_logits.astype(jnp.float32), axis=1), axis=1)
    s_zero = jnp.zeros((B, HG_HEADS, HG_HEAD_DIM, HG_HEAD_DIM), jnp.float32)
    for l in range(DEPTH):
        mod_x = jax.nn.silu(c) @ w_mod[l] + b_mod[l]
        mod_c = jax.nn.silu(c_ctx) @ w_mod[l] + b_mod[l]
        sh1, sc1, g1, sh2, sc2, g2 = jnp.split(mod_x[:, None, :], 6, axis=-1)
        csh1, csc1, cg1, csh2, csc2, cg2 = jnp.split(mod_c, 6, axis=-1)
        hx = rmsnorm(x, norm1_g[l]) * (1 + sc1) + sh1
        hc = rmsnorm(ctx, norm1_g[l]) * (1 + csc1) + csh1
        px = hx @ w_in[l]
        pc = hc @ w_in[l]
        hy_params = (hy_conv_w[l], hy_conv_b[l], hy_fw1[l], hy_fb1[l], hy_fw2[l], hy_fb2[l],
                     hy_fw3[l], hy_freq[l], hy_d[l])
        lb_f, lb_b = lower_bounds[0, l], lower_bounds[1, l]
        yc_hg, s_f, s_b = hgrn2_group(pc[..., 3 * HY_W:], lb_f, lb_b, hg_norm_g[l], s_zero, s_zero)
        yx_hg, _, _ = hgrn2_group(px[..., 3 * HY_W:], lb_f, lb_b, hg_norm_g[l], s_f, s_b)
        yx_hy = hyena_group(px[..., :3 * HY_W], rows, *hy_params)
        x = x + g1 * (jnp.concatenate([yx_hy, yx_hg], axis=-1) @ w_out[l])
        moe_params = (w_router[l], router_bias[l], ew_gate[l], ew_up[l], ew_down[l],
                      sw_gate[l], sw_up[l], sw_down[l])
        hx2 = rmsnorm(x, norm2_g[l]) * (1 + sc2) + sh2
        if l == DEPTH - 1:
            x = x + g2 * moe_ffn(hx2.reshape(B * L, D), *moe_params).reshape(B, L, D)
        else:
            yc_hy = hyena_group(pc[..., :3 * HY_W], None, *hy_params)
            ctx = ctx + cg1 * (jnp.concatenate([yc_hy, yc_hg], axis=-1) @ w_out[l])
            hc2 = rmsnorm(ctx, norm2_g[l]) * (1 + csc2) + csh2
            out = moe_ffn(jnp.concatenate([hx2.reshape(B * L, D), hc2.reshape(-1, D)], axis=0), *moe_params)
            x = x + g2 * out[:B * L].reshape(B, L, D)
            ctx = ctx + cg2 * out[B * L:].reshape(ctx.shape)
    return rmsnorm(x, final_g)
```

```cpp
#include <hip/hip_runtime.h>
#include <stdint.h>
#include <stdio.h>

#ifndef PROBE_HYENA
#define PROBE_HYENA 0
#endif
#ifndef PROBE_HGRN
#define PROBE_HGRN 0
#endif
#ifndef PROBE_SUB
#define PROBE_SUB 32
#endif
#ifndef PROBE_LIMIT
#define PROBE_LIMIT 670000u
#endif
#ifndef N_LAUNCH_SPLIT
#define N_LAUNCH_SPLIT 0
#endif

typedef unsigned short bf16_t;
typedef short bf16x8 __attribute__((ext_vector_type(8)));
typedef float f32x4 __attribute__((ext_vector_type(4)));
typedef float f32x2 __attribute__((ext_vector_type(2)));
typedef float f32x16 __attribute__((ext_vector_type(16)));
typedef unsigned u32x4 __attribute__((ext_vector_type(4)));
typedef unsigned u32x2 __attribute__((ext_vector_type(2)));
typedef _Float16 f16x2 __attribute__((ext_vector_type(2)));
typedef int i32x4 __attribute__((ext_vector_type(4)));
typedef int i32x8 __attribute__((ext_vector_type(8)));

constexpr int D = 1024, NB = 32, SEQ = 2048, T = NB * SEQ, CTX = 256, TC = NB * CTX;
constexpr int INC = 4096, HYW = 512, HGW = 512, NH = 4, HD = 128;
constexpr int NE = 256, TOPK = 8, FF = 256;
constexpr int NA = T * TOPK;
constexpr float EPS = 1e-6f;
constexpr float YSCALE = 16.0f;
constexpr float WSCALE = 32.0f;
constexpr float YMSCALE = 8.0f;
constexpr float HSCALE = 8.0f;
constexpr float W2SCALE = 16.0f;
constexpr int E8_1 = 0x7F7F7F7F, E8_2M5 = 0x7A7A7A7A, E8_2M3 = 0x7C7C7C7C, E8_2M4 = 0x7B7B7B7B;
constexpr int NTHREADS = 512;
constexpr int LDS_BYTES = 160 * 1024;

constexpr size_t MiB = 1ull << 20;
constexpr size_t WS_BAR = 0;
constexpr size_t WS_CNT = 16 * 1024;
constexpr size_t WS_DIFF = 48 * 1024;
constexpr size_t WS_CTL_BYTES = 64 * 1024;
constexpr size_t WS_MOD = 1 * MiB;
constexpr size_t WS_HNORM = 2 * MiB;
constexpr size_t WS_WIN = 4 * MiB;
constexpr size_t WS_WOUT = 12 * MiB;
constexpr size_t WS_WR = 14 * MiB;
constexpr size_t WS_FILT = 16 * MiB;
constexpr size_t WS_LIST = 960 * MiB;
constexpr size_t WS_WSLOT = 96 * MiB;
constexpr size_t WS_HX = 104 * MiB;
constexpr size_t WS_YMIX = 104 * MiB;
constexpr size_t WS_LG = 104 * MiB;
constexpr size_t WS_Y = 104 * MiB;
constexpr size_t WS_YSH = 616 * MiB;
constexpr size_t WS_U = 248 * MiB;
constexpr size_t WS_Q = 440 * MiB;
constexpr size_t WS_LF = 504 * MiB;
constexpr size_t WS_V = 632 * MiB;
constexpr size_t WS_G = 696 * MiB;
constexpr size_t WS_LFC = 760 * MiB;
constexpr size_t WS_VC = 776 * MiB;
constexpr size_t WS_O = 784 * MiB;
constexpr size_t WS_O2 = 912 * MiB;
constexpr size_t WS_YH = 1040 * MiB;
constexpr size_t WS_HX2 = 248 * MiB;
constexpr size_t WS_W1T = 376 * MiB;
constexpr size_t WS_HX2F8 = 505 * MiB;
constexpr size_t WS_W2T = 680 * MiB;
constexpr size_t WS_H = 809 * MiB;
constexpr size_t WS_END = 1104 * MiB;

extern __shared__ __attribute__((aligned(16))) unsigned char g_lds[];

struct Params {
    const float* x; const float* c; const float* ctx; const float* c_ctx; const float* w_mod; const float* b_mod;
    const float* norm1_g; const float* norm2_g; const float* w_in; const float* w_out; const float* hy_conv_w; const float* hy_conv_b;
    const float* fw1; const float* fb1; const float* fw2; const float* fb2; const float* fw3; const float* freq; const float* hy_d;
    const float* lb_logits; const float* hg_norm_g; const float* w_router; const float* router_bias;
    const float* ew_gate; const float* ew_up; const float* ew_down; const float* sw_gate; const float* sw_up; const float* sw_down; const float* final_g;
    float* out; unsigned char* ws; int ph_lo, ph_hi;
};

typedef __bf16 bf16v2_t __attribute__((ext_vector_type(2)));
__device__ __forceinline__ unsigned cvt_pk_bf16(float lo, float hi) { const f32x2 v = {lo, hi}; return __builtin_bit_cast(unsigned, __builtin_convertvector(v, bf16v2_t)); }
__device__ __forceinline__ float bf2f(unsigned short h) { return __uint_as_float((unsigned)h << 16); }
__device__ __forceinline__ float bflo(unsigned w) { return __uint_as_float(w << 16); }
__device__ __forceinline__ float bfhi(unsigned w) { return __uint_as_float(w & 0xffff0000u); }
__device__ __forceinline__ float sigmoidf_(float v) { return __builtin_amdgcn_rcpf(1.0f + __expf(-v)); }
__device__ __forceinline__ float siluf_(float v) { return v * __builtin_amdgcn_rcpf(1.0f + __expf(-v)); }
__device__ __forceinline__ float wave_sum(float v) {
#pragma unroll
    for (int o = 32; o > 0; o >>= 1) v += __shfl_xor(v, o);
    return v;
}
__device__ __forceinline__ unsigned pk_fp8x4(float a, float b, float c, float d) {
    a = fminf(fmaxf(a, -448.f), 448.f); b = fminf(fmaxf(b, -448.f), 448.f); c = fminf(fmaxf(c, -448.f), 448.f); d = fminf(fmaxf(d, -448.f), 448.f);
    int p = __builtin_amdgcn_cvt_pk_fp8_f32(a, b, 0, false);
    p = __builtin_amdgcn_cvt_pk_fp8_f32(c, d, p, true);
    return (unsigned)p;
}
__device__ __forceinline__ void acc_fp8x4(unsigned w, float& a, float& b, float& c, float& d) {
    f32x2 lo = __builtin_amdgcn_cvt_pk_f32_fp8((int)w, false), hi = __builtin_amdgcn_cvt_pk_f32_fp8((int)w, true);
    a += lo.x; b += lo.y; c += hi.x; d += hi.y;
}

#define XB_TMO      128
#define XB_XCNT(j)  (256  + 64 * (j))
#define XB_XSUB(j)  (1280 + 64 * (j))
#define XB_XGEN(j)  (2304 + 64 * (j))
#define XB_TOP      3328
#define XB_TOPGEN   3392
#define XCD_BAR_WORDS 3456
#define XB_SPIN_CAP (1u << 22)
#define LAS __attribute__((address_space(3)))
__device__ __forceinline__ unsigned xb_ld(unsigned* p)              { return __hip_atomic_load(p, __ATOMIC_RELAXED, __HIP_MEMORY_SCOPE_AGENT); }
__device__ __forceinline__ unsigned xb_add(unsigned* p, unsigned v) { return __hip_atomic_fetch_add(p, v, __ATOMIC_RELAXED, __HIP_MEMORY_SCOPE_AGENT); }
__device__ __forceinline__ unsigned xb_xcc_id() { return (unsigned)__builtin_amdgcn_s_getreg((3 << 11) | 20) & 0xFu; }
#define XB_SPIN(cond, bar) do { unsigned _sp = 0; while (cond) { __builtin_amdgcn_s_sleep(1); \
    if ((++_sp & 255u) == 0u) { if (xb_ld(&(bar)[XB_TMO])) break; if (_sp > XB_SPIN_CAP) { atomicAdd(&(bar)[XB_TMO], 1u); break; } } } } while (0)
struct XcdBarrier { unsigned* bar; unsigned x; volatile LAS unsigned* st; };
__device__ __forceinline__ XcdBarrier xcd_barrier_post(unsigned* bar, volatile LAS unsigned* st) {
    XcdBarrier b; b.bar = bar; b.x = xb_xcc_id(); b.st = st;
    if (threadIdx.x == 0) (void)xb_add(&bar[XB_XCNT(b.x)], 1u);
    return b;
}
__device__ __forceinline__ void xcd_barrier_complete(unsigned* bar, unsigned x, unsigned& nloc, unsigned& nx) {
    const unsigned G = gridDim.x * gridDim.y * gridDim.z;
    unsigned sum, cnt, mine, sp = 0u;
    for (;;) {
        sum = 0u; cnt = 0u; mine = 0u;
#pragma unroll
        for (unsigned j = 0; j < 16; ++j) { const unsigned c = xb_ld(&bar[XB_XCNT(j)]); sum += c; cnt += (c > 0u) ? 1u : 0u; mine = (j == x) ? c : mine; }
        if (sum == G) break;
        __builtin_amdgcn_s_sleep(1);
        if ((++sp & 255u) == 0u) { if (xb_ld(&bar[XB_TMO])) break; if (sp > XB_SPIN_CAP) { atomicAdd(&bar[XB_TMO], 1u); break; } }
    }
    nloc = mine > 0u ? mine : 1u; nx = cnt > 0u ? cnt : 1u;
}
__device__ __forceinline__ void xcd_barrier(const XcdBarrier& b) {
    asm volatile("s_waitcnt vmcnt(0)" ::: "memory");
    __syncthreads();
    if (threadIdx.x == 0) {
        unsigned* bar = b.bar;
        __builtin_amdgcn_s_waitcnt(0);
        unsigned nloc = b.st[0], nx = b.st[1];
        if (nloc == 0u) { xcd_barrier_complete(bar, b.x, nloc, nx); b.st[0] = nloc; b.st[1] = nx; }
        const unsigned old = xb_add(&bar[XB_XSUB(b.x)], 1u);
        const unsigned gen = old / nloc;
        if (old + 1u == (gen + 1u) * nloc) {
            __builtin_amdgcn_fence(__ATOMIC_RELEASE, "agent");
            asm volatile("s_waitcnt vmcnt(0)" ::: "memory");
            const unsigned og = xb_add(&bar[XB_TOP], 1u);
            const unsigned tg = og / nx;
            if (og + 1u == (tg + 1u) * nx) xb_add(&bar[XB_TOPGEN], 1u);
            else XB_SPIN(xb_ld(&bar[XB_TOPGEN]) == tg, bar);
            __builtin_amdgcn_fence(__ATOMIC_ACQUIRE, "agent");
            xb_add(&bar[XB_XGEN(b.x)], 1u);
            asm volatile("s_waitcnt vmcnt(0)" ::: "memory");
        } else {
            XB_SPIN(xb_ld(&bar[XB_XGEN(b.x)]) == gen, bar);
            __builtin_amdgcn_fence(__ATOMIC_ACQUIRE, "agent");
            asm volatile("s_waitcnt vmcnt(0)" ::: "memory");
        }
    }
    __syncthreads();
}

constexpr int G_HT = 128 * 64;
__device__ __forceinline__ int g_lds_byte(int r, int c) {
    int st = (r >> 4) * 2 + (c >> 5), rr = r & 15, cc = c & 31, ob = rr * 64 + cc * 2;
    return st * 1024 + (ob ^ (((ob >> 9) & 1) << 5));
}
__device__ __forceinline__ void g_stage_rc(int b, int& R, int& C) {
    int st = b / 1024, sb = b % 1024, swz = sb ^ (((sb >> 9) & 1) << 5);
    R = (st >> 1) * 16 + swz / 64; C = (st & 1) * 32 + (swz % 64) / 2;
}
__device__ __forceinline__ void g_thread_rc(int& R0, int& C0) { g_stage_rc((int)threadIdx.x * 16, R0, C0); }

#define G_SA(b, h) (shm + ((b) * 2 + (h)) * G_HT)
#define G_SB(b, h) (shm + (4 + (b) * 2 + (h)) * G_HT)
#define G_RSRC(ptr, bytes) __builtin_amdgcn_make_buffer_rsrc((void*)(ptr), (short)0, (int)(bytes), 0x00020000)
#define G_DMA(P, RS, VO, SO) __builtin_amdgcn_raw_ptr_buffer_load_lds(RS, (LAS void*)((char*)(P) + wbase), 16, (int)(VO), (int)(SO), 0, 0)
#define G_STAGE_A(P, h, kt) do { \
    if (GATHER) { G_DMA(P, ra, av[(h) * 2 + 0], (unsigned)(kt) * 128u); G_DMA((char*)(P) + 8192, ra, av[(h) * 2 + 1], (unsigned)(kt) * 128u); } \
    else { G_DMA(P, ra, av[0], asoff + (unsigned)((h) * 128) * ald + (unsigned)(kt) * 128u); G_DMA((char*)(P) + 8192, ra, av[0], asoff + (unsigned)((h) * 128 + 64) * ald + (unsigned)(kt) * 128u); } } while (0)
#define G_STAGE_B(P, h, kt) do { \
    G_DMA(P, rb, bv, bsoff + (unsigned)((h) * BHS) * bld + (unsigned)(kt) * 128u); G_DMA((char*)(P) + 8192, rb, bv, bsoff + (unsigned)((h) * BHS + BPS) * bld + (unsigned)(kt) * 128u); } while (0)
#define G_LDA(dst, b, h) for (int m = 0; m < 4; ++m) for (int k = 0; k < 2; ++k) \
    dst[m][k] = *reinterpret_cast<const bf16x8*>((char*)G_SA(b, h) + g_lds_byte(wr * 64 + m * 16 + fr, k * 32 + fq * 8))
#define G_LDB(dst, b, h) for (int n = 0; n < 2; ++n) for (int k = 0; k < 2; ++k) \
    dst[n][k] = *reinterpret_cast<const bf16x8*>((char*)G_SB(b, h) + g_lds_byte(wc * 32 + n * 16 + fr, k * 32 + fq * 8))
#define G_MMA(ai, bj, At, Bt) do { __builtin_amdgcn_s_setprio(1); \
    for (int m = 0; m < 4; ++m) for (int n = 0; n < 2; ++n) for (int k = 0; k < 2; ++k) \
      acc[ai][bj][m][n] = __builtin_amdgcn_mfma_f32_16x16x32_bf16(Bt[n][k], At[m][k], acc[ai][bj][m][n], 0, 0, 0); \
    __builtin_amdgcn_s_setprio(0); } while (0)
#define G_LDA8(dst, b, h) _Pragma("unroll") for (int m = 0; m < 4; ++m) { \
    const i32x4 lo_ = *reinterpret_cast<const i32x4*>((char*)G_SA(b, h) + g_lds_byte(wr * 64 + m * 16 + fr, fq * 8)); \
    const i32x4 hi_ = *reinterpret_cast<const i32x4*>((char*)G_SA(b, h) + g_lds_byte(wr * 64 + m * 16 + fr, 32 + fq * 8)); \
    dst[m] = (i32x8){lo_.x, lo_.y, lo_.z, lo_.w, hi_.x, hi_.y, hi_.z, hi_.w}; }
#define G_LDB8(dst, b, h) _Pragma("unroll") for (int n = 0; n < 2; ++n) { \
    const i32x4 lo_ = *reinterpret_cast<const i32x4*>((char*)G_SB(b, h) + g_lds_byte(wc * 32 + n * 16 + fr, fq * 8)); \
    const i32x4 hi_ = *reinterpret_cast<const i32x4*>((char*)G_SB(b, h) + g_lds_byte(wc * 32 + n * 16 + fr, 32 + fq * 8)); \
    dst[n] = (i32x8){lo_.x, lo_.y, lo_.z, lo_.w, hi_.x, hi_.y, hi_.z, hi_.w}; }
__device__ __forceinline__ void mfma8_tied(f32x4& c, const i32x8& a, const i32x8& b, int sa, int sb) {
    asm volatile("v_mfma_scale_f32_16x16x128_f8f6f4 %0, %1, %2, %0, %3, %4 op_sel_hi:[0,0,0]" : "+v"(c) : "v"(a), "v"(b), "v"(sa), "v"(sb));
}
__device__ __forceinline__ void mfma8_first(f32x4& c, const i32x8& a, const i32x8& b, int sa, int sb) {
    asm volatile("v_mfma_scale_f32_16x16x128_f8f6f4 %0, %1, %2, 0, %3, %4 op_sel_hi:[0,0,0]" : "=&v"(c) : "v"(a), "v"(b), "v"(sa), "v"(sb));
}
#define G_MMA8F(ai, bj, At, Bt) do { __builtin_amdgcn_s_setprio(1); \
    _Pragma("unroll") for (int m = 0; m < 4; ++m) _Pragma("unroll") for (int n = 0; n < 2; ++n) \
      mfma8_first(acc[ai][bj][m][n], Bt[n], At[m], SCW, SCA); \
    __builtin_amdgcn_s_setprio(0); } while (0)
#define G_MMA8(ai, bj, At, Bt) do { __builtin_amdgcn_s_setprio(1); \
    _Pragma("unroll") for (int m = 0; m < 4; ++m) _Pragma("unroll") for (int n = 0; n < 2; ++n) \
      mfma8_tied(acc[ai][bj][m][n], Bt[n], At[m], SCW, SCA); \
    __builtin_amdgcn_s_setprio(0); } while (0)
#define G_WAIT_V(n) asm volatile("s_waitcnt vmcnt(" #n ")" ::: "memory")
#define G_WAIT_L(n) asm volatile("s_waitcnt lgkmcnt(" #n ")" ::: "memory")
#define G_BAR __builtin_amdgcn_s_barrier()
#define G_SCHED __builtin_amdgcn_sched_barrier(0)

#define G_KLOOP(LDA_, LDB_, MMA_) \
    G_STAGE_B(G_SB(0, 0), 0, 0); G_STAGE_A(G_SA(0, 0), 0, 0); \
    G_STAGE_B(G_SB(0, 1), 1, 0); G_STAGE_A(G_SA(0, 1), 1, 0); \
    if (wr == 1) G_BAR; \
    G_WAIT_V(4); G_BAR; \
    G_STAGE_B(G_SB(1, 0), 0, 1); G_STAGE_A(G_SA(1, 0), 0, 1); G_STAGE_B(G_SB(1, 1), 1, 1); \
    G_WAIT_V(6); G_BAR; \
    for (int t = 0; t < nt - 2; t += 2) { \
        LDB_(B0, 0, 0); G_SCHED; LDA_(At, 0, 0); G_STAGE_A(G_SA(1, 1), 1, t + 1); \
        G_WAIT_L(8); G_BAR; MMA_(0, 0, At, B0); G_BAR; G_SCHED; \
        LDB_(B1, 0, 1); G_STAGE_B(G_SB(0, 0), 0, t + 2); \
        G_BAR; MMA_(0, 1, At, B1); G_BAR; \
        LDA_(At, 0, 1); G_STAGE_A(G_SA(0, 0), 0, t + 2); \
        G_BAR; MMA_(1, 0, At, B0); G_BAR; G_SCHED; \
        G_STAGE_B(G_SB(0, 1), 1, t + 2); \
        G_WAIT_V(6); G_BAR; MMA_(1, 1, At, B1); G_BAR; \
        LDB_(B0, 1, 0); G_SCHED; LDA_(At, 1, 0); G_STAGE_A(G_SA(0, 1), 1, t + 2); \
        G_WAIT_L(8); G_BAR; MMA_(0, 0, At, B0); G_BAR; G_SCHED; \
        LDB_(B1, 1, 1); G_STAGE_B(G_SB(1, 0), 0, t + 3); \
        G_BAR; MMA_(0, 1, At, B1); G_BAR; \
        LDA_(At, 1, 1); G_STAGE_A(G_SA(1, 0), 0, t + 3); \
        G_BAR; MMA_(1, 0, At, B0); G_BAR; G_SCHED; \
        G_STAGE_B(G_SB(1, 1), 1, t + 3); \
        G_WAIT_V(6); G_BAR; MMA_(1, 1, At, B1); G_BAR; \
    } \
    asm volatile("" : "+v"(tz)); wid = tz >> 6; lane = tz & 63; wr = wid >> 2; wc = wid & 3; fr = lane & 15; fq = lane >> 4; \
    { LDB_(B0, 0, 0); G_WAIT_V(0); LDA_(At, 0, 0); G_STAGE_A(G_SA(1, 1), 1, nt - 1); \
      G_BAR; G_WAIT_L(0); MMA_(0, 0, At, B0); G_BAR; \
      LDB_(B1, 0, 1); G_BAR; G_WAIT_L(0); MMA_(0, 1, At, B1); G_BAR; \
      LDA_(At, 0, 1); G_WAIT_V(4); G_BAR; G_WAIT_L(0); MMA_(1, 0, At, B0); MMA_(1, 1, At, B1); G_BAR; } \
    { LDB_(B0, 1, 0); LDA_(At, 1, 0); G_WAIT_V(2); G_BAR; G_WAIT_L(0); MMA_(0, 0, At, B0); G_BAR; \
      LDB_(B1, 1, 1); G_WAIT_V(0); G_BAR; G_WAIT_L(0); MMA_(0, 1, At, B1); G_BAR; \
      LDA_(At, 1, 1); G_BAR; G_WAIT_L(0); MMA_(1, 0, At, B0); MMA_(1, 1, At, B1); G_BAR; } \
    if (wr == 0) G_BAR;

template <bool GATHER, bool F8, int SCW, int SCA, int BHS, int BPS, class EPI>
__device__ __forceinline__ void gemm_unit_x(__amdgpu_buffer_rsrc_t ra, const unsigned (&av)[4], const unsigned asoff, const unsigned ald,
                                          __amdgpu_buffer_rsrc_t rb, const unsigned bv, const unsigned bsoff, const unsigned bld, const int nt_in, EPI& epi) {
    bf16_t* shm = (bf16_t*)g_lds;
    int tz = threadIdx.x;
    int wid = tz >> 6, lane = tz & 63, wr = wid >> 2, wc = wid & 3, fr = lane & 15, fq = lane >> 4;
    const int wbase = __builtin_amdgcn_readfirstlane(wid * 1024);
    f32x4 acc[2][2][4][2] = {};
    int nt = nt_in; asm volatile("" : "+s"(nt));
    if constexpr (F8) {
        i32x8 At[4], B0[2], B1[2];
        G_KLOOP(G_LDA8, G_LDB8, G_MMA8)
        asm volatile("s_nop 15\n\ts_nop 15" ::: "memory");
    } else {
        bf16x8 At[4][2], B0[2][2], B1[2][2];
        G_KLOOP(G_LDA, G_LDB, G_MMA)
    }
    epi(acc, wr, wc, fr, fq);
}
template <bool GATHER, bool F8, int SCW, int SCA, class EPI>
__device__ __forceinline__ void gemm_unit(__amdgpu_buffer_rsrc_t ra, const unsigned (&av)[4], const unsigned asoff, const unsigned ald,
                                          __amdgpu_buffer_rsrc_t rb, const unsigned bv, const unsigned bsoff, const unsigned bld, const int nt_in, EPI& epi) {
    gemm_unit_x<GATHER, F8, SCW, SCA, 128, 64, EPI>(ra, av, asoff, ald, rb, bv, bsoff, bld, nt_in, epi);
}

struct GU {
    __amdgpu_buffer_rsrc_t ra, rb;
    unsigned av[4];
    unsigned asoff, bsoff;
    int t0, t1, t2;
};
#define S_STAGE_A(P, U, h, kt) do { \
    if (GATHER) { G_DMA(P, U##ra, ((h) ? U##a2 : U##a0), (unsigned)(kt) * 128u); G_DMA((char*)(P) + 8192, U##ra, ((h) ? U##a3 : U##a1), (unsigned)(kt) * 128u); } \
    else { G_DMA(P, U##ra, U##a0, U##aso + (unsigned)((h) * 128) * ald + (unsigned)(kt) * 128u); \
           G_DMA((char*)(P) + 8192, U##ra, U##a0, U##aso + (unsigned)((h) * 128 + 64) * ald + (unsigned)(kt) * 128u); } } while (0)
#define S_STAGE_B(P, U, h, kt) do { \
    G_DMA(P, U##rb, bv, U##bso + (unsigned)((h) * 128) * bld + (unsigned)(kt) * 128u); \
    G_DMA((char*)(P) + 8192, U##rb, bv, U##bso + (unsigned)((h) * 128 + 64) * bld + (unsigned)(kt) * 128u); } while (0)
#define S_LOAD(U, G) do { U##ra = (G).ra; U##rb = (G).rb; U##a0 = (G).av[0]; U##a1 = (G).av[1]; U##a2 = (G).av[2]; U##a3 = (G).av[3]; U##aso = (G).asoff; U##bso = (G).bsoff; } while (0)
template <bool GATHER, int SCW, int SCA, class SRC, class EPI>
__device__ __forceinline__ void gemm_stream(SRC& srcf, EPI& epi, const unsigned ald, const unsigned bld, const unsigned bv, const int nt_in) {
    bf16_t* shm = (bf16_t*)g_lds;
    int tz = threadIdx.x;
    int wid = tz >> 6, lane = tz & 63, wr = wid >> 2, wc = wid & 3, fr = lane & 15, fq = lane >> 4;
    const int wbase = __builtin_amdgcn_readfirstlane(wid * 1024);
    int nt = nt_in; asm volatile("" : "+s"(nt));
    GU cu, nx; int ui = 0;
    if (!srcf(0, cu)) return;
    __amdgpu_buffer_rsrc_t c_ra, c_rb, n_ra, n_rb, s_ra, s_rb;
    unsigned c_a0, c_a1, c_a2, c_a3, c_aso, c_bso, n_a0, n_a1, n_a2, n_a3, n_aso, n_bso, s_a0, s_a1, s_a2, s_a3, s_aso, s_bso;
    S_LOAD(c_, cu);
    f32x4 acc[2][2][4][2];
#pragma unroll
    for (int a_ = 0; a_ < 2; ++a_)
#pragma unroll
        for (int b_ = 0; b_ < 2; ++b_)
#pragma unroll
            for (int m_ = 0; m_ < 4; ++m_)
#pragma unroll
                for (int n_ = 0; n_ < 2; ++n_) acc[a_][b_][m_][n_] = (f32x4){0.f, 0.f, 0.f, 0.f};
    i32x8 At[4], B0[2], B1[2];
    S_STAGE_B(G_SB(0, 0), c_, 0, 0); S_STAGE_A(G_SA(0, 0), c_, 0, 0); S_STAGE_B(G_SB(0, 1), c_, 1, 0); S_STAGE_A(G_SA(0, 1), c_, 1, 0);
    if (wr == 1) G_BAR;
    G_WAIT_V(4); G_BAR;
    S_STAGE_B(G_SB(1, 0), c_, 0, 1); S_STAGE_A(G_SA(1, 0), c_, 0, 1); S_STAGE_B(G_SB(1, 1), c_, 1, 1);
    G_WAIT_V(6); G_BAR;
#pragma unroll 1
    for (;;) {
        const bool has_next = srcf(ui + 1, nx);
        if (has_next) { S_LOAD(n_, nx); }
        else { n_ra = c_ra; n_rb = c_rb; n_a0 = c_a0; n_a1 = c_a1; n_a2 = c_a2; n_a3 = c_a3; n_aso = c_aso; n_bso = c_bso; }
#pragma unroll 1
        for (int t = 0; t < nt; t += 2) {
            const bool last = (t == nt - 2);
            s_ra = last ? n_ra : c_ra; s_rb = last ? n_rb : c_rb; s_a0 = last ? n_a0 : c_a0; s_a1 = last ? n_a1 : c_a1; s_a2 = last ? n_a2 : c_a2; s_a3 = last ? n_a3 : c_a3;
            s_aso = last ? n_aso : c_aso; s_bso = last ? n_bso : c_bso;
            const int k2 = last ? 0 : t + 2;
            G_LDB8(B0, 0, 0); G_SCHED; G_LDA8(At, 0, 0); S_STAGE_A(G_SA(1, 1), c_, 1, t + 1);
            G_WAIT_L(8); G_BAR; G_MMA8(0, 0, At, B0); G_BAR; G_SCHED;
            G_LDB8(B1, 0, 1); S_STAGE_B(G_SB(0, 0), s_, 0, k2);
            G_BAR; G_MMA8(0, 1, At, B1); G_BAR;
            G_LDA8(At, 0, 1); S_STAGE_A(G_SA(0, 0), s_, 0, k2);
            G_BAR; G_MMA8(1, 0, At, B0); G_BAR; G_SCHED;
            S_STAGE_B(G_SB(0, 1), s_, 1, k2);
            G_WAIT_V(6); G_BAR; G_MMA8(1, 1, At, B1); G_BAR;
            G_LDB8(B0, 1, 0); G_SCHED; G_LDA8(At, 1, 0); S_STAGE_A(G_SA(0, 1), s_, 1, k2);
            G_WAIT_L(8); G_BAR; G_MMA8(0, 0, At, B0); G_BAR; G_SCHED;
            G_LDB8(B1, 1, 1); S_STAGE_B(G_SB(1, 0), s_, 0, k2 + 1);
            G_BAR; G_MMA8(0, 1, At, B1); G_BAR;
            G_LDA8(At, 1, 1); S_STAGE_A(G_SA(1, 0), s_, 0, k2 + 1);
            G_BAR; G_MMA8(1, 0, At, B0); G_BAR; G_SCHED;
            S_STAGE_B(G_SB(1, 1), s_, 1, k2 + 1);
            G_WAIT_V(6); G_BAR; G_MMA8(1, 1, At, B1); G_BAR;
        }
        asm volatile("s_nop 15\n\ts_nop 15" ::: "memory");
        epi(acc, cu, wr, wc, fr, fq);
        srcf.after(ui);
        if (!has_next) break;
#pragma unroll
        for (int a_ = 0; a_ < 2; ++a_)
#pragma unroll
            for (int b_ = 0; b_ < 2; ++b_)
#pragma unroll
                for (int m_ = 0; m_ < 4; ++m_)
#pragma unroll
                    for (int n_ = 0; n_ < 2; ++n_) acc[a_][b_][m_][n_] = (f32x4){0.f, 0.f, 0.f, 0.f};
        cu = nx; S_LOAD(c_, cu); ++ui;
    }
    G_WAIT_V(0);
    if (wr == 0) G_BAR;
    G_BAR;
}
__device__ __forceinline__ int perm32(int rho) { const int n = rho >> 4, i = rho & 15; return 8 * (i >> 2) + 4 * n + (i & 3); }
__device__ __forceinline__ unsigned dense_voff_perm(int ld) { int R0, C0; g_thread_rc(R0, C0); const int Rp = (R0 & ~31) + perm32(R0 & 31); return (unsigned)(Rp * ld + C0) * 2u; }

__device__ __forceinline__ unsigned dense_voff(int ld) { int R0, C0; g_thread_rc(R0, C0); return (unsigned)(R0 * ld + C0) * 2u; }

template <class RM>
__device__ __forceinline__ void tcvt_tile(const float* __restrict__ src, int C, int r0, int c0, bf16_t* __restrict__ dst, int dld, RM rm) {
    float* tile = (float*)g_lds;
    const int t = threadIdx.x;
    {
        const int r = t >> 4, c4 = (t & 15) * 4;
#pragma unroll
        for (int i = 0; i < 2; ++i) {
            const f32x4 v = *(const f32x4*)(src + (size_t)(r0 + r + 32 * i) * C + c0 + c4);
            float* d = tile + (r + 32 * i) * 65 + c4;
            d[0] = v[0]; d[1] = v[1]; d[2] = v[2]; d[3] = v[3];
        }
    }
    __syncthreads();
    {
        const int cc = t >> 3, rr = (t & 7) * 8;
        float v[8];
#pragma unroll
        for (int e = 0; e < 8; ++e) v[e] = tile[(rr + e) * 65 + cc];
        u32x4 w; w.x = cvt_pk_bf16(v[0], v[1]); w.y = cvt_pk_bf16(v[2], v[3]); w.z = cvt_pk_bf16(v[4], v[5]); w.w = cvt_pk_bf16(v[6], v[7]);
        *(u32x4*)(dst + (size_t)rm(c0 + cc) * dld + r0 + rr) = w;
    }
    __syncthreads();
}
template <class RM>
__device__ __forceinline__ void tcvt_tile_f8(const float* __restrict__ src, int C, int r0, int c0, unsigned char* __restrict__ dst, int dld, RM rm, float scale) {
    float* tile = (float*)g_lds;
    const int t = threadIdx.x;
    {
        const int r = t >> 4, c4 = (t & 15) * 4;
#pragma unroll
        for (int i = 0; i < 2; ++i) {
            const f32x4 v = *(const f32x4*)(src + (size_t)(r0 + r + 32 * i) * C + c0 + c4);
            float* d = tile + (r + 32 * i) * 65 + c4;
            d[0] = v[0]; d[1] = v[1]; d[2] = v[2]; d[3] = v[3];
        }
    }
    __syncthreads();
    {
        const int cc = t >> 3, rr = (t & 7) * 8;
        float v[8];
#pragma unroll
        for (int e = 0; e < 8; ++e) v[e] = tile[(rr + e) * 65 + cc] * scale;
        u32x2 w; w.x = pk_fp8x4(v[0], v[1], v[2], v[3]); w.y = pk_fp8x4(v[4], v[5], v[6], v[7]);
        *(u32x2*)(dst + (size_t)rm(c0 + cc) * dld + r0 + rr) = w;
    }
    __syncthreads();
}
template <class RM>
__device__ __forceinline__ void tcvt_wide_f8(const float* __restrict__ src, int C, int r0, int c0, unsigned char* __restrict__ dst, int dld, RM rm, float scale) {
    float* tile = (float*)g_lds;
    const int t = threadIdx.x;
    {
        const int r = t >> 6, c4 = (t & 63) * 4;
        f32x4 v[8];
#pragma unroll
        for (int i = 0; i < 8; ++i) v[i] = *(const f32x4*)(src + (size_t)(r0 + r + 8 * i) * C + c0 + c4);
#pragma unroll
        for (int i = 0; i < 8; ++i) *(f32x4*)(tile + (r + 8 * i) * 260 + c4) = v[i];
    }
    __syncthreads();
    {
#pragma unroll
        for (int q = 0; q < 4; ++q) {
            const int cc = q * 64 + (t >> 3), rr = (t & 7) * 8;
            float v[8];
#pragma unroll
            for (int e = 0; e < 8; ++e) v[e] = tile[(rr + e) * 260 + cc] * scale;
            u32x2 w; w.x = pk_fp8x4(v[0], v[1], v[2], v[3]); w.y = pk_fp8x4(v[4], v[5], v[6], v[7]);
            *(u32x2*)(dst + (size_t)rm(c0 + cc) * dld + r0 + rr) = w;
        }
    }
    __syncthreads();
}
struct RmId { __device__ __forceinline__ int operator()(int n) const { return n; } };
struct RmGU { int add; __device__ __forceinline__ int operator()(int n) const { return (n >> 7) * 256 + add + (n & 127); } };

__device__ __forceinline__ void phase_a(const Params& p, int bid, int nb) {
    const int tid = threadIdx.x;
    float* lds = (float*)g_lds;
#ifndef REP_A1
#define REP_A1 1
#endif
#ifndef REP_A2
#define REP_A2 1
#endif
#ifndef REP_A3
#define REP_A3 1
#endif
#pragma unroll 1
    for (int ra1_ = 0; ra1_ < REP_A1; ++ra1_)
    for (int u = bid; u < 256; u += nb) {
#pragma unroll 6
        for (int it = 0; it < 17; ++it) {
            const int i4 = tid + NTHREADS * it;
            if (i4 < 33 * 256) { const int r = i4 >> 8, k4 = (i4 & 255) * 4;
                const f32x4 v = r < 32 ? *(const f32x4*)(p.c + r * 1024 + k4) : *(const f32x4*)(p.c_ctx + k4);
                *(f32x4*)(lds + i4 * 4) = (f32x4){siluf_(v[0]), siluf_(v[1]), siluf_(v[2]), siluf_(v[3])}; }
        }
        __syncthreads();
        float acc[33];
#pragma unroll
        for (int r = 0; r < 33; ++r) acc[r] = 0.f;
        const int cl = tid % 24, ks = tid / 24;
        if (ks < 16) {
            const float* wp = p.w_mod + (size_t)(ks * 64) * 6144 + u * 24 + cl;
#pragma unroll 1
            for (int k0 = 0; k0 < 64; k0 += 16) {
                float wv[16];
#pragma unroll
                for (int j = 0; j < 16; ++j) wv[j] = wp[(size_t)(k0 + j) * 6144];
#pragma unroll
                for (int j = 0; j < 16; ++j) {
                    const float* sk = lds + ks * 64 + k0 + j;
#pragma unroll
                    for (int r = 0; r < 33; ++r) acc[r] += sk[r * 1024] * wv[j];
                }
            }
        }
        __syncthreads();
        if (ks < 16) {
#pragma unroll
            for (int r = 0; r < 33; ++r) lds[(ks * 33 + r) * 24 + cl] = acc[r];
        }
        __syncthreads();
        for (int o = tid; o < 33 * 24; o += NTHREADS) {
            float s = 0.f;
#pragma unroll
            for (int k = 0; k < 16; ++k) s += lds[k * 33 * 24 + o];
            const int r = o / 24, col = u * 24 + o % 24;
            ((float*)(p.ws + WS_MOD))[r * 6144 + col] = s + p.b_mod[col];
        }
        __syncthreads();
    }
#pragma unroll 1
    for (int ra2_ = 0; ra2_ < REP_A2; ++ra2_)
    for (int u = bid; u < 256; u += nb) {
        float* feats = lds;
        float* h1 = lds + 512;
        float* h2 = lds + 1024;
        float* w1s = lds + 2048;
        float* w2s = lds + 2048 + 2112;
        for (int i = tid; i < 2112; i += NTHREADS) w1s[i] = p.fw1[i];
#pragma unroll
        for (int i = 0; i < 8; ++i) w2s[tid + 512 * i] = p.fw2[tid + 512 * i];
        if (tid < 8 * 33) {
            const int pp = tid / 33, j = tid % 33; const int pos = u * 8 + pp;
            const float posf = (float)pos; const float tt = posf / 2047.0f; const float w = (6.283185307179586f / 2048.0f) * posf;
            float v;
            if (j == 0) v = tt;
            else { const int bi = (j - 1) & 15; const float band = 1e-4f + (15.0f - 1e-4f) * ((float)bi / 15.0f); const float a = band * w; v = (j <= 16) ? cosf(a) : -sinf(a); }
            feats[pp * 33 + j] = v;
        }
        __syncthreads();
        { const int pp = tid >> 6, j = tid & 63; float a = p.fb1[j];
#pragma unroll 11
          for (int k = 0; k < 33; ++k) a += feats[pp * 33 + k] * w1s[k * 64 + j];
          h1[pp * 64 + j] = sinf(p.freq[j] * a); }
        __syncthreads();
        { const int pp = tid >> 6, j = tid & 63; float a = p.fb2[j];
#pragma unroll 16
          for (int k = 0; k < 64; ++k) a += h1[pp * 64 + k] * w2s[k * 64 + j];
          h2[pp * 64 + j] = sinf(p.freq[j] * a); }
        __syncthreads();
        {
            float acc[4][8];
#pragma unroll
            for (int i = 0; i < 4; ++i)
#pragma unroll
                for (int pp = 0; pp < 8; ++pp) acc[i][pp] = 0.f;
#pragma unroll 1
            for (int k0 = 0; k0 < 64; k0 += 8) {
                float wv[8][4];
#pragma unroll
                for (int j = 0; j < 8; ++j)
#pragma unroll
                    for (int i = 0; i < 4; ++i) wv[j][i] = p.fw3[(k0 + j) * 2048 + tid + 512 * i];
#pragma unroll
                for (int j = 0; j < 8; ++j)
#pragma unroll
                    for (int pp = 0; pp < 8; ++pp) { const float hv = h2[pp * 64 + k0 + j];
#pragma unroll
                        for (int i = 0; i < 4; ++i) acc[i][pp] += hv * wv[j][i]; }
            }
            const int ch = tid;
            const float mind = -4.605170185988091f / 1.5f, maxd = -4.605170185988091f / 0.3f;
            const float delta = fabsf(mind + (maxd - mind) * ((float)ch / 511.0f));
            float* filt = (float*)(p.ws + WS_FILT);
            float* hn = (float*)(p.ws + WS_HNORM) + (size_t)u * 1024;
#pragma unroll
            for (int o = 0; o < 2; ++o) {
                float s = 0.f;
                float* R = filt + ((size_t)o * 512 + ch) * 4096;
                float fv[8], bv[8];
#pragma unroll
                for (int pp = 0; pp < 8; ++pp) {
                    const int pos = u * 8 + pp; const float tt = (float)pos / 2047.0f; const float win = __expf(-tt * delta);
                    fv[pp] = acc[2 * o][pp] * win; bv[pp] = acc[2 * o + 1][pp] * win;
                    s += fabsf(fv[pp]) + fabsf(bv[pp]);
                }
                if (u == 0) { fv[0] += bv[0]; }
                *(f32x4*)(R + 2040 - 8 * u) = (f32x4){fv[7], fv[6], fv[5], fv[4]};
                *(f32x4*)(R + 2044 - 8 * u) = (f32x4){fv[3], fv[2], fv[1], fv[0]};
                if (u == 0) { R[2048] = bv[1]; R[2049] = bv[2]; R[2050] = bv[3]; R[2051] = bv[4]; R[2052] = bv[5]; R[2053] = bv[6]; R[2054] = bv[7]; R[4095] = 0.f; }
                else {
#pragma unroll
                    for (int pp = 0; pp < 8; ++pp) R[2047 + 8 * u + pp] = bv[pp];
                }
                hn[o * 512 + ch] = s;
            }
        }
        __syncthreads();
    }
#pragma unroll 1
    for (int ra3_ = 0; ra3_ < REP_A3; ++ra3_)
    for (int tIdx = bid; tIdx < 256 + 64 + 16; tIdx += nb) {
        if (tIdx < 256) tcvt_wide_f8(p.w_in, 4096, (tIdx >> 4) * 64, (tIdx & 15) * 256, p.ws + WS_WIN, 1024, RmId(), WSCALE);
        else if (tIdx < 320) { const int q = tIdx - 256; tcvt_wide_f8(p.w_out, 1024, (q >> 2) * 64, (q & 3) * 256, p.ws + WS_WOUT, 1024, RmId(), WSCALE); }
        else { const int q = tIdx - 320;
#pragma unroll
            for (int c = 0; c < 4; ++c) tcvt_tile(p.w_router, 256, q * 64, c * 64, (bf16_t*)(p.ws + WS_WR), 1024, RmId()); }
    }
}

template <int MODE, class BF>
__device__ __forceinline__ void norm_rows(const float* __restrict__ src, int rows, const float* __restrict__ g, const float* __restrict__ mod, int sh, int sc,
                                          bf16_t* __restrict__ dst, unsigned char* __restrict__ dst8, BF batch_of, int bid, int nb) {
    const int wid = threadIdx.x >> 6, lane = threadIdx.x & 63;
    for (int tile = bid; tile * 256 < rows; tile += nb) {
        const float* mrow = mod + (size_t)batch_of(tile * 256) * 6144;
        f32x4 gs[4], shv[4];
#pragma unroll
        for (int i = 0; i < 4; ++i) {
            const int col = i * 256 + lane * 4;
            const f32x4 gv = *(const f32x4*)(g + col), scv = *(const f32x4*)(mrow + sc * 1024 + col);
            shv[i] = *(const f32x4*)(mrow + sh * 1024 + col);
#pragma unroll
            for (int j = 0; j < 4; ++j) gs[i][j] = gv[j] * (1.0f + scv[j]);
        }
#pragma unroll 4
        for (int k = 0; k < 32; ++k) {
            const int r = tile * 256 + wid + 8 * k;
            const float* xr = src + (size_t)r * 1024;
            f32x4 v[4]; float ss = 0.f;
#pragma unroll
            for (int i = 0; i < 4; ++i) {
                if (MODE == 2) {
                    const u32x2 w = *(const u32x2*)((const unsigned char*)xr + (i * 256 + lane * 4) * 2);
                    v[i] = (f32x4){__uint_as_float(w.x << 16), __uint_as_float(w.x & 0xffff0000u), __uint_as_float(w.y << 16), __uint_as_float(w.y & 0xffff0000u)};
                } else v[i] = *(const f32x4*)(xr + i * 256 + lane * 4);
                ss += v[i][0] * v[i][0] + v[i][1] * v[i][1] + v[i][2] * v[i][2] + v[i][3] * v[i][3];
            }
            ss = wave_sum(ss);
            const float rs = rsqrtf(ss * (1.0f / 1024.0f) + EPS);
#pragma unroll
            for (int i = 0; i < 4; ++i) {
                const int col = i * 256 + lane * 4;
                float o[4];
#pragma unroll
                for (int j = 0; j < 4; ++j) o[j] = (v[i][j] * rs) * gs[i][j] + shv[i][j];
                if (MODE != 1) { u32x2 w; w.x = cvt_pk_bf16(o[0], o[1]); w.y = cvt_pk_bf16(o[2], o[3]); *(u32x2*)(dst + (size_t)r * 1024 + col) = w; }
                if (MODE != 0) *(unsigned*)(dst8 + (size_t)r * 1024 + col) = pk_fp8x4(o[0], o[1], o[2], o[3]);
            }
        }
    }
}
struct BatchLat { __device__ __forceinline__ int operator()(int r) const { return r >> 11; } };
struct BatchCtx { __device__ __forceinline__ int operator()(int) const { return 32; } };

constexpr int LDS_CONVW = 131072 + 8192;
struct EpiHy {
    const Params* p; int pm, pn;
    __device__ __forceinline__ void operator()(f32x4 (&acc)[2][2][4][2], int wr, int wc, int fr, int fq) const {
        int tz = threadIdx.x; asm volatile("" : "+v"(tz));
        const int lane = tz & 63, fq_ = lane >> 4, fr_ = lane & 15;
        const int up = ((lane - 16) & 63) * 4, dn = ((lane + 16) & 63) * 4;
        const int b = pm >> 3, t0 = (pm & 7) * 256;
        bf16_t* U = (bf16_t*)(p->ws + WS_U);
        const float* cw = (const float*)(g_lds + LDS_CONVW) + ((pn >> 2) & 1) * 1024;
#pragma unroll
        for (int ai = 0; ai < 2; ++ai)
#pragma unroll
            for (int m = 0; m < 4; ++m) {
                const int cl = ai * 128 + wr * 64 + m * 16 + fr_;
                const float w0 = cw[cl], w1 = cw[256 + cl], w2 = cw[512 + cl], cb = cw[768 + cl];
                float x0[8], x1[8];
#pragma unroll
                for (int n = 0; n < 2; ++n)
#pragma unroll
                    for (int j = 0; j < 4; ++j) { x0[n * 4 + j] = acc[ai][0][m][n][j]; x1[n * 4 + j] = acc[ai][1][m][n][j]; }
                const float l0r = __int_as_float(__builtin_amdgcn_ds_bpermute(up, __float_as_int(x0[7])));
                const float l1 = __int_as_float(__builtin_amdgcn_ds_bpermute(up, __float_as_int(fq_ == 3 ? x0[7] : x1[7])));
                const float r0 = __int_as_float(__builtin_amdgcn_ds_bpermute(dn, __float_as_int(fq_ == 0 ? x1[0] : x0[0])));
                const float r1r = __int_as_float(__builtin_amdgcn_ds_bpermute(dn, __float_as_int(x1[0])));
                const float l0 = fq_ > 0 ? l0r : 0.f, r1 = fq_ < 3 ? r1r : 0.f;
                bf16_t* dst = U + ((size_t)(pn * 256 + cl) * 32 + b) * 2048 + t0 + 64 * wc + 8 * fq_;
                {
                    float o[8];
#pragma unroll
                    for (int e = 0; e < 8; ++e) o[e] = w0 * (e == 0 ? l0 : x0[e - 1]) + w1 * x0[e] + w2 * (e == 7 ? r0 : x0[e + 1]) + cb;
                    u32x4 w; w.x = cvt_pk_bf16(o[0], o[1]); w.y = cvt_pk_bf16(o[2], o[3]); w.z = cvt_pk_bf16(o[4], o[5]); w.w = cvt_pk_bf16(o[6], o[7]);
                    *(u32x4*)dst = w;
                }
                {
                    float o[8];
#pragma unroll
                    for (int e = 0; e < 8; ++e) o[e] = w0 * (e == 0 ? l1 : x1[e - 1]) + w1 * x1[e] + w2 * (e == 7 ? r1 : x1[e + 1]) + cb;
                    u32x4 w; w.x = cvt_pk_bf16(o[0], o[1]); w.y = cvt_pk_bf16(o[2], o[3]); w.z = cvt_pk_bf16(o[4], o[5]); w.w = cvt_pk_bf16(o[6], o[7]);
                    *(u32x4*)(dst + 32) = w;
                }
            }
    }
};
struct EpiP1 {
    const Params* p; int pm, pn, isctx;
    __device__ __forceinline__ void operator()(f32x4 (&acc)[2][2][4][2], int wr, int wc, int fr, int fq) const {
        unsigned char* ws = p->ws;
        const int tid = threadIdx.x;
        if (pn < 6) {
            float* stg = (float*)g_lds;
            const int b = pm >> 3, t0 = (pm & 7) * 256;
            bf16_t* U = (bf16_t*)(ws + WS_U);
#ifndef REP_C_HYEPI
#define REP_C_HYEPI 1
#endif
#pragma unroll 1
            for (int rep_ = 0; rep_ < REP_C_HYEPI; ++rep_)
#pragma unroll
            for (int ai = 0; ai < 2; ++ai) {
#pragma unroll
                for (int bj = 0; bj < 2; ++bj)
#pragma unroll
                    for (int m = 0; m < 4; ++m)
#pragma unroll
                        for (int n = 0; n < 2; ++n)
#pragma unroll
                            for (int j = 0; j < 4; ++j) stg[(bj * 128 + wc * 32 + n * 16 + 4 * fq + j) * 132 + wr * 64 + m * 16 + fr] = acc[ai][bj][m][n][j];
                __syncthreads();
                {
                    const int col = tid >> 1, hr = tid & 1, c3 = pn * 256 + col;
                    const float w0 = p->hy_conv_w[c3], w1 = p->hy_conv_w[1536 + c3], w2 = p->hy_conv_w[3072 + c3], cb = p->hy_conv_b[c3];
                    const float* s = stg + col * 132 + hr * 64;
                    bf16_t* dst = U + ((size_t)c3 * 32 + b) * 2048 + t0 + ai * 128 + hr * 64;
                    float prev = 0.f;
#pragma unroll
                    for (int ch = 0; ch < 8; ++ch) {
                        float v[9];
#pragma unroll
                        for (int e = 0; e < 8; ++e) v[e] = s[ch * 8 + e];
                        v[8] = (ch < 7) ? s[ch * 8 + 8] : 0.f;
                        float o[8];
#pragma unroll
                        for (int e = 0; e < 8; ++e) { const float l = (e == 0) ? prev : v[e - 1]; o[e] = w0 * l + w1 * v[e] + w2 * v[e + 1] + cb; }
                        prev = v[7];
                        u32x4 w; w.x = cvt_pk_bf16(o[0], o[1]); w.y = cvt_pk_bf16(o[2], o[3]); w.z = cvt_pk_bf16(o[4], o[5]); w.w = cvt_pk_bf16(o[6], o[7]);
                        *(u32x4*)(dst + ch * 8) = w;
                    }
                }
                __syncthreads();
            }
            return;
        }
        const int grp = (pn - 6) >> 1;
        const int half = (pn - 6) & 1;
        unsigned char* tile = g_lds;
#pragma unroll
        for (int bj = 0; bj < 2; ++bj)
#pragma unroll
            for (int n = 0; n < 2; ++n) {
                float lbv[4] = {0.f, 0.f, 0.f, 0.f};
                if (grp == 1 || grp == 2) {
                    const float* lg = p->lb_logits + (grp - 1) * 1024 + (half * 2 + bj) * 128 + wc * 32 + n * 16 + 4 * fq;
#pragma unroll
                    for (int j = 0; j < 4; ++j) lbv[j] = __builtin_amdgcn_rcpf(1.0f + __expf(lg[512 + j] - lg[j]));
                }
#pragma unroll
                for (int ai = 0; ai < 2; ++ai)
#pragma unroll
                    for (int m = 0; m < 4; ++m) {
                        const int rl = ai * 128 + wr * 64 + m * 16 + fr;
                        const f32x4 v = acc[ai][bj][m][n];
                        u32x2 w;
                        if (grp == 0) {
                            const float sc = 0.08838834764831845f;
                            w.x = cvt_pk_bf16(siluf_(v[0]) * sc, siluf_(v[1]) * sc); w.y = cvt_pk_bf16(siluf_(v[2]) * sc, siluf_(v[3]) * sc);
                        } else if (grp == 1 || grp == 2) {
                            float lf[4];
#pragma unroll
                            for (int j = 0; j < 4; ++j) { const float lb = lbv[j]; lf[j] = __logf(lb + (1.0f - lb) * sigmoidf_(v[j])); }
                            f16x2 h0, h1; h0.x = (_Float16)lf[0]; h0.y = (_Float16)lf[1]; h1.x = (_Float16)lf[2]; h1.y = (_Float16)lf[3];
                            w.x = __builtin_bit_cast(unsigned, h0); w.y = __builtin_bit_cast(unsigned, h1);
                        } else if (grp == 3) {
                            w.x = cvt_pk_bf16(v[0], v[1]); w.y = cvt_pk_bf16(v[2], v[3]);
                        } else {
                            w.x = cvt_pk_bf16(siluf_(v[0]), siluf_(v[1])); w.y = cvt_pk_bf16(siluf_(v[2]), siluf_(v[3]));
                        }
                        *(u32x2*)(tile + rl * 528 + (bj * 128 + wc * 32 + n * 16 + 4 * fq) * 2) = w;
                    }
            }
        __syncthreads();
        {
            const int LL = isctx ? CTX : SEQ;
            unsigned char* base;
            if (grp == 0) base = ws + WS_Q;
            else if (grp == 1 || grp == 2) base = (isctx ? ws + WS_LFC : ws + WS_LF) + (size_t)(grp - 1) * 32 * 4 * LL * 256;
            else if (grp == 3) base = isctx ? ws + WS_VC : ws + WS_V;
            else base = ws + WS_G;
            int tz = threadIdx.x; asm volatile("" : "+v"(tz));
#pragma unroll
            for (int i = 0; i < 16; ++i) {
                const int idx = tz + 512 * i, rl = idx >> 5, c16 = idx & 31;
                int b, t;
                if (isctx) { b = pm; t = rl; } else { b = pm >> 3; t = (pm & 7) * 256 + rl; }
                unsigned char* dst;
                if (grp == 4) dst = base + ((size_t)b * SEQ + t) * 1024 + half * 512 + c16 * 16;
                else dst = base + ((((size_t)b * 4 + half * 2 + (c16 >> 4)) * LL + t) * 128) * 2 + (c16 & 15) * 16;
                *(u32x4*)dst = *(const u32x4*)(tile + rl * 528 + c16 * 16);
            }
        }
        __syncthreads();
    }
};

constexpr int LDS_LB = 131072 + 16384;
struct EpiP1D {
    const Params* p; int pm, pn, isctx;
    __device__ __forceinline__ void operator()(f32x4 (&acc)[2][2][4][2], int wr, int wc, int fr, int fq) const {
        unsigned char* ws = p->ws;
        const int grp = (pn - 6) >> 1, half = (pn - 6) & 1;
        const int LL = isctx ? CTX : SEQ;
        unsigned char* base;
        if (grp == 0) base = ws + WS_Q;
        else if (grp == 1 || grp == 2) base = (isctx ? ws + WS_LFC : ws + WS_LF) + (size_t)(grp - 1) * 32 * 4 * LL * 256;
        else if (grp == 3) base = isctx ? ws + WS_VC : ws + WS_V;
        else base = ws + WS_G;
        int tz = threadIdx.x; asm volatile("" : "+v"(tz));
        const int fr_ = tz & 15, fq_ = (tz >> 4) & 3;
        const int b = isctx ? pm : pm >> 3, t0 = isctx ? 0 : (pm & 7) * 256;
#pragma unroll
        for (int bj = 0; bj < 2; ++bj) {
            const int c8 = wc * 32 + 8 * fq_;
            float lbv[8];
            if (grp == 1 || grp == 2) {
                const float* lb = (const float*)(g_lds + LDS_LB) + (grp - 1) * 512 + (half * 2 + bj) * 128 + c8;
                const f32x4 l0 = *(const f32x4*)lb, l1 = *(const f32x4*)(lb + 4);
                lbv[0] = l0[0]; lbv[1] = l0[1]; lbv[2] = l0[2]; lbv[3] = l0[3]; lbv[4] = l1[0]; lbv[5] = l1[1]; lbv[6] = l1[2]; lbv[7] = l1[3];
            }
            unsigned char* cb;
            if (grp == 4) cb = base + ((size_t)b * SEQ + t0) * 1024 + half * 512 + (bj * 128 + c8) * 2;
            else cb = base + (((size_t)b * 4 + half * 2 + bj) * LL + t0) * 256 + c8 * 2;
            const int rstride = grp == 4 ? 1024 : 256;
#pragma unroll
            for (int ai = 0; ai < 2; ++ai)
#pragma unroll
                for (int m = 0; m < 4; ++m) {
                    const int rl = ai * 128 + wr * 64 + m * 16 + fr_;
                    float v[8];
#pragma unroll
                    for (int n = 0; n < 2; ++n)
#pragma unroll
                        for (int j = 0; j < 4; ++j) v[n * 4 + j] = acc[ai][bj][m][n][j];
                    u32x4 w;
                    if (grp == 0) {
                        const float sc = 0.08838834764831845f;
#pragma unroll
                        for (int j = 0; j < 8; ++j) v[j] = siluf_(v[j]) * sc;
                        w.x = cvt_pk_bf16(v[0], v[1]); w.y = cvt_pk_bf16(v[2], v[3]); w.z = cvt_pk_bf16(v[4], v[5]); w.w = cvt_pk_bf16(v[6], v[7]);
                    } else if (grp == 1 || grp == 2) {
#pragma unroll
                        for (int j = 0; j < 8; ++j) v[j] = __logf(lbv[j] + (1.0f - lbv[j]) * sigmoidf_(v[j]));
                        f16x2 h0, h1, h2, h3; h0.x = (_Float16)v[0]; h0.y = (_Float16)v[1]; h1.x = (_Float16)v[2]; h1.y = (_Float16)v[3];
                        h2.x = (_Float16)v[4]; h2.y = (_Float16)v[5]; h3.x = (_Float16)v[6]; h3.y = (_Float16)v[7];
                        w.x = __builtin_bit_cast(unsigned, h0); w.y = __builtin_bit_cast(unsigned, h1); w.z = __builtin_bit_cast(unsigned, h2); w.w = __builtin_bit_cast(unsigned, h3);
                    } else if (grp == 3) {
                        w.x = cvt_pk_bf16(v[0], v[1]); w.y = cvt_pk_bf16(v[2], v[3]); w.z = cvt_pk_bf16(v[4], v[5]); w.w = cvt_pk_bf16(v[6], v[7]);
                    } else {
#pragma unroll
                        for (int j = 0; j < 8; ++j) v[j] = siluf_(v[j]);
                        w.x = cvt_pk_bf16(v[0], v[1]); w.y = cvt_pk_bf16(v[2], v[3]); w.z = cvt_pk_bf16(v[4], v[5]); w.w = cvt_pk_bf16(v[6], v[7]);
                    }
                    *(u32x4*)(cb + (size_t)rl * rstride) = w;
                }
        }
    }
};
__device__ __forceinline__ void load_convw(const Params& p, int pn, int& cached) {
    if (pn == cached) return;
    cached = pn;
    __syncthreads();
    if (threadIdx.x < 256) {
        const int c3 = pn * 256 + threadIdx.x; float* cw = (float*)(g_lds + LDS_CONVW) + ((pn >> 2) & 1) * 1024;
        cw[threadIdx.x] = p.hy_conv_w[c3]; cw[256 + threadIdx.x] = p.hy_conv_w[1536 + c3]; cw[512 + threadIdx.x] = p.hy_conv_w[3072 + c3]; cw[768 + threadIdx.x] = p.hy_conv_b[c3];
    }
}
__device__ __forceinline__ void phase_c(const Params& p, int bid, int nb) {
    int cw_pn = -1;
    unsigned tokv;
    { int R0, C0; g_thread_rc(R0, C0); tokv = (unsigned)(64 * (R0 >> 5) + perm32(R0 & 31)) * 1024u + (unsigned)C0 * 2u; }
    const __amdgpu_buffer_rsrc_t ra = G_RSRC(p.ws + WS_HX, (size_t)(T + TC) * 1024);
    const __amdgpu_buffer_rsrc_t rb = G_RSRC(p.ws + WS_WIN, (size_t)4096 * 1024);
    unsigned av[4]; av[0] = dense_voff(512); av[1] = av[2] = av[3] = 0u;
    const unsigned bv = dense_voff_perm(512);
    __syncthreads();
    for (int i = threadIdx.x; i < 1024; i += NTHREADS) {
        const float* lg = p.lb_logits + (i >> 9) * 1024 + (i & 511);
        ((float*)(g_lds + LDS_LB))[i] = __builtin_amdgcn_rcpf(1.0f + __expf(lg[512] - lg[0]));
    }
    __syncthreads();
    if ((nb & 31) == 0) {
        const int x = bid & 7, r = bid >> 3, R = nb >> 3, G = R >> 2;
        const int xq = x & 3, xh = x >> 2, q4 = r & 3, s = r >> 2;
        const int nlat = (128 - s + G - 1) / G;
        const int ncx = 16 * (xq < 2 ? 2 : 1), nctx = r < ncx ? (ncx - r + R - 1) / R : 0;
        load_convw(p, xq, cw_pn);
        if (xq < 2) load_convw(p, xq + 4, cw_pn);
        __syncthreads();
        for (int j = 0; j < nlat + nctx; ++j) {
            EpiP1D e; e.p = &p;
            int arow;
            if (j < nlat) { e.pm = xh * 128 + s + G * j; e.pn = xq + 4 * ((q4 + j) & 3); e.isctx = 0; arow = e.pm * 256; }
            else { const int u = r + R * (j - nlat); e.pm = xh * 16 + (u & 15); e.pn = xq + 8 + 4 * (u >> 4); e.isctx = 1; arow = T + e.pm * 256; }
            if (e.pn < 6) { EpiHy eh; eh.p = &p; eh.pm = e.pm; eh.pn = e.pn;
                gemm_unit_x<false, true, E8_1, E8_2M5, 32, 128>(rb, av, (unsigned)(e.pn * 256) * 1024u, 1024u, ra, tokv, (unsigned)arow * 1024u, 1024u, 8, eh); }
            else
            gemm_unit<false, true, E8_2M5, E8_1>(ra, av, (unsigned)arow * 1024u, 1024u, rb, bv, (unsigned)(e.pn * 256) * 1024u, 1024u, 8, e);
        }
    } else
    for (int u = bid; u < 4096 + 192; u += nb) {
        EpiP1D e; e.p = &p;
        int arow;
        if (u < 4096) { e.pm = u >> 4; e.pn = u & 15; e.isctx = 0; arow = e.pm * 256; }
        else { const int q = u - 4096; e.pm = q / 6; e.pn = 8 + q % 6; e.isctx = 1; arow = T + e.pm * 256; }
        if (e.pn < 6) { load_convw(p, e.pn, cw_pn); EpiHy eh; eh.p = &p; eh.pm = e.pm; eh.pn = e.pn;
            gemm_unit_x<false, true, E8_1, E8_2M5, 32, 128>(rb, av, (unsigned)(e.pn * 256) * 1024u, 1024u, ra, tokv, (unsigned)arow * 1024u, 1024u, 8, eh); }
        else
        gemm_unit<false, true, E8_2M5, E8_1>(ra, av, (unsigned)arow * 1024u, 1024u, rb, bv, (unsigned)(e.pn * 256) * 1024u, 1024u, 8, e);
    }
}

__device__ __forceinline__ void phase_hgrn_naive(const Params& p, int bid, int nb, size_t o_off) {
    const int tid = threadIdx.x, v = tid & 127, dq = tid >> 7;
    float* lds = (float*)g_lds;
    float* fs = lds; float* ks = lds + 128; float* vs = lds + 256; float* qs = lds + 384; float* red = lds + 512;
    const unsigned char* ws = p.ws;
    for (int u = bid; u < 256; u += nb) {
        const int dir = u & 1, h = (u >> 1) & 3, b = u >> 3;
        float S[32];
#pragma unroll
        for (int i = 0; i < 32; ++i) S[i] = 0.f;
        const _Float16* lfc = (const _Float16*)(ws + WS_LFC) + (((size_t)dir * 32 + b) * 4 + h) * CTX * 128;
        const bf16_t* vc = (const bf16_t*)(ws + WS_VC) + ((size_t)b * 4 + h) * CTX * 128;
        const _Float16* lfl = (const _Float16*)(ws + WS_LF) + (((size_t)dir * 32 + b) * 4 + h) * SEQ * 128;
        const bf16_t* vl = (const bf16_t*)(ws + WS_V) + ((size_t)b * 4 + h) * SEQ * 128;
        const bf16_t* ql = (const bf16_t*)(ws + WS_Q) + ((size_t)b * 4 + h) * SEQ * 128;
        bf16_t* O = (bf16_t*)(p.ws + o_off) + (size_t)dir * T * 512;
        const int NS = CTX + SEQ;
        float nxt = 0.f;
        { const int t = dir ? CTX - 1 : 0;
          if (dq == 0) nxt = (float)lfc[t * 128 + v]; else if (dq == 1) nxt = bf2f(vc[t * 128 + v]); }
        for (int s = 0; s < NS; ++s) {
            const bool lat = s >= CTX;
#if PROBE_HGRN == 6
            if (s == CTX) {
#pragma unroll
                for (int i = 0; i < 32; ++i) S[i] = 0.f;
            }
#endif
            const float cur = nxt;
            if (s + 1 < NS) {
                const int s1 = s + 1;
                if (s1 < CTX) { const int t = dir ? CTX - 1 - s1 : s1;
                    if (dq == 0) nxt = (float)lfc[t * 128 + v]; else if (dq == 1) nxt = bf2f(vc[t * 128 + v]); }
                else { const int i = s1 - CTX; const int t = dir ? SEQ - 1 - i : i;
                    if (dq == 0) nxt = (float)lfl[(size_t)t * 128 + v]; else if (dq == 1) nxt = bf2f(vl[(size_t)t * 128 + v]); else if (dq == 2) nxt = bf2f(ql[(size_t)t * 128 + v]); }
            }
            if (dq == 0) { const float f = __expf(cur); fs[v] = f; ks[v] = 1.0f - f; } else if (dq == 1) vs[v] = cur; else if (dq == 2) qs[v] = cur;
            __syncthreads();
            const float vv = vs[v];
            float po = 0.f;
#pragma unroll
            for (int dd = 0; dd < 32; ++dd) { const int d = dq * 32 + dd; S[dd] = fs[d] * S[dd] + ks[d] * vv; po += S[dd] * qs[d]; }
            if (lat) {
                red[dq * 128 + v] = po;
                __syncthreads();
                if (dq == 0) { const int i = s - CTX; const int t = dir ? SEQ - 1 - i : i;
                    O[((size_t)b * SEQ + t) * 512 + h * 128 + v] = (bf16_t)(cvt_pk_bf16(red[v] + red[128 + v] + red[256 + v] + red[384 + v], 0.f) & 0xffffu); }
            }
            __syncthreads();
        }
    }
}

__device__ __forceinline__ f32x16 zero_acc16() {
    float z = 0.f; asm volatile("" : "+v"(z));
    f32x16 a;
#pragma unroll
    for (int r = 0; r < 16; ++r) a[r] = z;
    return a;
}
constexpr int HG_RAWQ = 0, HG_ATT = 0, HG_RAWL = 16384, HG_RAWV = 32768, HG_QM = 49152, HG_KM = 66560, HG_KMT = 83968, HG_VT = 102400, HG_ST = 120832, HG_GSUM = 155648;
__device__ __forceinline__ void phase_hgrn_mfma(const Params& p, int bid, int nb, size_t o_off = WS_O) {
    const int tid = threadIdx.x, lane = tid & 63, w = tid >> 6, li = lane & 31, hh = lane >> 5;
    unsigned char* L = g_lds;
    float* gsum = (float*)(L + HG_GSUM);
    for (int u = bid; u < 256; u += nb) {
        const int dir = u & 1, h = (u >> 1) & 3, b = u >> 3;
        const unsigned char* lfc = p.ws + WS_LFC + ((((size_t)dir * 32 + b) * 4 + h) * CTX) * 256;
        const unsigned char* vc = p.ws + WS_VC + (((size_t)b * 4 + h) * CTX) * 256;
        const unsigned char* lfl = p.ws + WS_LF + ((((size_t)dir * 32 + b) * 4 + h) * SEQ) * 256;
        const unsigned char* vl = p.ws + WS_V + (((size_t)b * 4 + h) * SEQ) * 256;
        const unsigned char* ql = p.ws + WS_Q + (((size_t)b * 4 + h) * SEQ) * 256;
        bf16_t* O = (bf16_t*)(p.ws + o_off) + (size_t)dir * T * 512;
        f32x16 S[2];
#pragma unroll
        for (int j = 0; j < 2; ++j)
#pragma unroll
            for (int r = 0; r < 16; ++r) S[j][r] = 0.f;
        u32x4 pq[2], pl[2], pv[2];
        { const int lr = tid >> 3, lpart = tid & 7;
          const int t = dir ? CTX - 1 - lr : lr;
          pl[0] = *(const u32x4*)(lfc + t * 256 + lpart * 32); pl[1] = *(const u32x4*)(lfc + t * 256 + lpart * 32 + 16);
          pv[0] = *(const u32x4*)(vc + t * 256 + lpart * 32); pv[1] = *(const u32x4*)(vc + t * 256 + lpart * 32 + 16);
          pq[0] = (u32x4){0u, 0u, 0u, 0u}; pq[1] = pq[0]; }
#pragma unroll 1
        for (int n = 0; n < 36; ++n) {
            const bool lat = n >= 4;
            int tz = tid; asm volatile("" : "+v"(tz));
            const int ed = tz & 127, ecg = tz >> 7;
            const int lr = tz >> 3, lpart = tz & 7;
            *(u32x4*)(L + HG_RAWQ + lr * 256 + lpart * 32) = pq[0]; *(u32x4*)(L + HG_RAWQ + lr * 256 + lpart * 32 + 16) = pq[1];
            *(u32x4*)(L + HG_RAWL + lr * 256 + lpart * 32) = pl[0]; *(u32x4*)(L + HG_RAWL + lr * 256 + lpart * 32 + 16) = pl[1];
            *(u32x4*)(L + HG_RAWV + lr * 256 + lpart * 32) = pv[0]; *(u32x4*)(L + HG_RAWV + lr * 256 + lpart * 32 + 16) = pv[1];
            if (n + 1 < 36) {
                const int n1 = n + 1;
                if (n1 < 4) { const int i = 64 * n1 + lr; const int t = dir ? CTX - 1 - i : i;
                    pl[0] = *(const u32x4*)(lfc + t * 256 + lpart * 32); pl[1] = *(const u32x4*)(lfc + t * 256 + lpart * 32 + 16);
                    pv[0] = *(const u32x4*)(vc + t * 256 + lpart * 32); pv[1] = *(const u32x4*)(vc + t * 256 + lpart * 32 + 16); }
                else { const int i = 64 * (n1 - 4) + lr; const size_t t = dir ? SEQ - 1 - i : i;
                    pl[0] = *(const u32x4*)(lfl + t * 256 + lpart * 32); pl[1] = *(const u32x4*)(lfl + t * 256 + lpart * 32 + 16);
                    pv[0] = *(const u32x4*)(vl + t * 256 + lpart * 32); pv[1] = *(const u32x4*)(vl + t * 256 + lpart * 32 + 16);
                    pq[0] = *(const u32x4*)(ql + t * 256 + lpart * 32); pq[1] = *(const u32x4*)(ql + t * 256 + lpart * 32 + 16); }
            }
            __syncthreads();
            float bl[16];
            { float run = 0.f;
#pragma unroll
              for (int i = 0; i < 16; ++i) { run += (float)*(const _Float16*)(L + HG_RAWL + (16 * ecg + i) * 256 + 2 * ed); bl[i] = run; }
              gsum[ecg * 128 + ed] = run; }
            __syncthreads();
            {
                const float g0 = gsum[ed], g1 = gsum[128 + ed], g2 = gsum[256 + ed];
                const float off = (ecg > 0 ? g0 : 0.f) + (ecg > 1 ? g1 : 0.f) + (ecg > 2 ? g2 : 0.f);
                const float bmid = g0 + g1;
                unsigned kp[8], vp[8];
#pragma unroll
                for (int i = 0; i < 16; i += 2) {
                    float km2[2];
#pragma unroll
                    for (int e = 0; e < 2; ++e) {
                        const int c = 16 * ecg + i + e;
                        const float bb = bl[i + e] + off;
                        const float f = __expf((i + e) ? bl[i + e] - bl[i + e - 1] : bl[0]);
                        const float e1 = __expf(bb - bmid), e2 = __expf(bmid - bb);
                        const float km = (1.0f - f) * e2;
                        km2[e] = km;
                        *(bf16_t*)(L + HG_KM + c * 272 + 2 * ed) = (bf16_t)(cvt_pk_bf16(km, 0.f) & 0xffffu);
                        if (lat) { const float qv = bf2f(*(const bf16_t*)(L + HG_RAWQ + c * 256 + 2 * ed));
                            *(bf16_t*)(L + HG_QM + c * 272 + 2 * ed) = (bf16_t)(cvt_pk_bf16(qv * e1, 0.f) & 0xffffu); }
                    }
                    kp[i >> 1] = cvt_pk_bf16(km2[0], km2[1]);
                    vp[i >> 1] = (unsigned)*(const bf16_t*)(L + HG_RAWV + (16 * ecg + i) * 256 + 2 * ed) | ((unsigned)*(const bf16_t*)(L + HG_RAWV + (16 * ecg + i + 1) * 256 + 2 * ed) << 16);
                }
                *(u32x4*)(L + HG_KMT + ed * 144 + 32 * ecg) = (u32x4){kp[0], kp[1], kp[2], kp[3]};
                *(u32x4*)(L + HG_KMT + ed * 144 + 32 * ecg + 16) = (u32x4){kp[4], kp[5], kp[6], kp[7]};
                *(u32x4*)(L + HG_VT + ed * 144 + 32 * ecg) = (u32x4){vp[0], vp[1], vp[2], vp[3]};
                *(u32x4*)(L + HG_VT + ed * 144 + 32 * ecg + 16) = (u32x4){vp[4], vp[5], vp[6], vp[7]};
            }
#if PROBE_HGRN == 6
            if (n == 4) {
#pragma unroll
                for (int j = 0; j < 2; ++j)
#pragma unroll
                    for (int r = 0; r < 16; ++r) S[j][r] = 0.f;
            }
#endif
            if (lat) {
                const int dt = w >> 1;
#pragma unroll
                for (int g = 0; g < 4; ++g) {
                    const int d0 = dt * 32 + 8 * g + 4 * hh;
                    const f32x4 a0 = *(const f32x4*)(gsum + d0), a1 = *(const f32x4*)(gsum + 128 + d0);
                    const float s0 = __expf(a0[0] + a1[0]), s1 = __expf(a0[1] + a1[1]), s2 = __expf(a0[2] + a1[2]), s3 = __expf(a0[3] + a1[3]);
#pragma unroll
                    for (int j = 0; j < 2; ++j) {
                        const int v = (2 * (w & 1) + j) * 32 + li;
                        u32x2 wv;
                        wv.x = cvt_pk_bf16(S[j][4 * g + 0] * s0, S[j][4 * g + 1] * s1);
                        wv.y = cvt_pk_bf16(S[j][4 * g + 2] * s2, S[j][4 * g + 3] * s3);
                        *(u32x2*)(L + HG_ST + v * 272 + 2 * d0) = wv;
                    }
                }
            }
            __syncthreads();
#if PROBE_HGRN == 7 && (PROBE_SUB & 1)
            if (lat) {
                const int c = tid >> 3, d = (tid & 7) * 16 + (n & 15);
                float bc = 0.f, bm = 0.f, lfc_ = 0.f;
#pragma unroll 1
                for (int cc = 0; cc < 64; ++cc) { const int i = 64 * (n - 4) + cc; const size_t t = dir ? SEQ - 1 - i : i;
                    const float l = (float)*(const _Float16*)(lfl + t * 256 + 2 * d);
                    if (cc <= c) bc += l; if (cc <= 31) bm += l; if (cc == c) lfc_ = l; }
                const int i = 64 * (n - 4) + c; const size_t t = dir ? SEQ - 1 - i : i;
                const float qv = bf2f(*(const bf16_t*)(ql + t * 256 + 2 * d));
                const float kmr = (1.0f - __expf(lfc_)) * __expf(bm - bc), qmr = qv * __expf(bc - bm);
                const float kml = bf2f(*(const bf16_t*)(L + HG_KM + c * 272 + 2 * d)), qml = bf2f(*(const bf16_t*)(L + HG_QM + c * 272 + 2 * d));
                const float kmt = bf2f(*(const bf16_t*)(L + HG_KMT + d * 144 + 2 * c));
                unsigned badA = 0;
                if (!(fabsf(kml - kmr) <= 0.02f * fabsf(kmr) + 1e-30f)) ++badA;
                if (!(fabsf(qml - qmr) <= 0.02f * fabsf(qmr) + 1e-30f)) ++badA;
                if (!(fabsf(kmt - kmr) <= 0.02f * fabsf(kmr) + 1e-30f)) ++badA;
                const unsigned short vraw = *(const bf16_t*)(vl + t * 256 + 2 * d), vlds = *(const bf16_t*)(L + HG_VT + d * 144 + 2 * c);
                unsigned badB = (vraw != vlds) ? 1u : 0u;
                if (badA) atomicAdd((unsigned*)(p.ws + WS_DIFF) + 0, badA);
                if (badB) atomicAdd((unsigned*)(p.ws + WS_DIFF) + 1, badB);
            }
#endif
#if PROBE_HGRN == 7 && (PROBE_SUB & 8)
            if (lat) {
                const int c = tid >> 3, d = (tid & 7) * 16 + (n & 15);
                float bc = 0.f, bm = 0.f, lfc_ = 0.f;
#pragma unroll 1
                for (int cc = 0; cc < 64; ++cc) { const int i = 64 * (n - 4) + cc; const size_t t = dir ? SEQ - 1 - i : i;
                    const float l = (float)*(const _Float16*)(lfl + t * 256 + 2 * d);
                    if (cc <= c) bc += l; if (cc <= 31) bm += l; if (cc == c) lfc_ = l; }
                const float kmr = (1.0f - __expf(lfc_)) * __expf(bm - bc);
                const float kml = bf2f(*(const bf16_t*)(L + HG_KM + c * 272 + 2 * d));
                if (!(fabsf(kml - kmr) <= 0.02f * fabsf(kmr) + 1e-30f)) atomicAdd((unsigned*)(p.ws + WS_DIFF) + 0, 1u);
            }
#endif
#if PROBE_HGRN == 7 && (PROBE_SUB & 32)
            if (lat) {
                const int c = tid >> 3, d = (tid & 7) * 16 + (n & 15);
                float bc = 0.f, bm = 0.f;
#pragma unroll 1
                for (int cc = 0; cc < 64; ++cc) { const int i = 64 * (n - 4) + cc; const size_t t = dir ? SEQ - 1 - i : i;
                    const float l = (float)*(const _Float16*)(lfl + t * 256 + 2 * d);
                    if (cc <= c) bc += l; if (cc <= 31) bm += l; }
                const int i = 64 * (n - 4) + c; const size_t t = dir ? SEQ - 1 - i : i;
                const float qmr = bf2f(*(const bf16_t*)(ql + t * 256 + 2 * d)) * __expf(bc - bm);
                const float qml = bf2f(*(const bf16_t*)(L + HG_QM + c * 272 + 2 * d));
                if (!(fabsf(qml - qmr) <= 0.02f * fabsf(qmr) + 1e-30f)) atomicAdd((unsigned*)(p.ws + WS_DIFF) + 2, 1u);
            }
#endif
#if PROBE_HGRN == 7 && (PROBE_SUB & 16)
            if (lat) {
                const int c = tid >> 3, d = (tid & 7) * 16 + (n & 15);
                const int i = 64 * (n - 4) + c; const size_t t = dir ? SEQ - 1 - i : i;
                const unsigned short vraw = *(const bf16_t*)(vl + t * 256 + 2 * d), vlds = *(const bf16_t*)(L + HG_VT + d * 144 + 2 * c);
                if (vraw != vlds) atomicAdd((unsigned*)(p.ws + WS_DIFF) + 1, 1u);
            }
#endif
            f32x16 accU0 = zero_acc16(), accU1 = zero_acc16();
            {
                const int dt = w >> 1, vt0 = 2 * (w & 1);
#pragma unroll
                for (int kk = 0; kk < 4; ++kk) {
                    const bf16x8 a = *(const bf16x8*)(L + HG_KMT + (dt * 32 + li) * 144 + 2 * (16 * kk + 8 * hh));
                    const bf16x8 b0 = *(const bf16x8*)(L + HG_VT + (vt0 * 32 + li) * 144 + 2 * (16 * kk + 8 * hh));
                    const bf16x8 b1 = *(const bf16x8*)(L + HG_VT + ((vt0 + 1) * 32 + li) * 144 + 2 * (16 * kk + 8 * hh));
                    accU0 = __builtin_amdgcn_mfma_f32_32x32x16_bf16(a, b0, accU0, 0, 0, 0);
                    accU1 = __builtin_amdgcn_mfma_f32_32x32x16_bf16(a, b1, accU1, 0, 0, 0);
                }
            }
            if (lat) {
                if (w < 4) {
                    const int st = w >> 1, ct = w & 1;
                    f32x16 acc = zero_acc16();
                    if (!(st == 1 && ct == 0)) {
#pragma unroll
                        for (int kk = 0; kk < 8; ++kk) {
                            const bf16x8 a = *(const bf16x8*)(L + HG_KM + (st * 32 + li) * 272 + 2 * (16 * kk + 8 * hh));
                            const bf16x8 bq = *(const bf16x8*)(L + HG_QM + (ct * 32 + li) * 272 + 2 * (16 * kk + 8 * hh));
                            acc = __builtin_amdgcn_mfma_f32_32x32x16_bf16(a, bq, acc, 0, 0, 0);
                        }
                    }
                    const int c = ct * 32 + li;
#pragma unroll
                    for (int g = 0; g < 4; ++g) {
                        const int s0 = st * 32 + 8 * g + 4 * hh;
                        u32x2 wv;
                        wv.x = cvt_pk_bf16(s0 + 0 <= c ? acc[4 * g + 0] : 0.f, s0 + 1 <= c ? acc[4 * g + 1] : 0.f);
                        wv.y = cvt_pk_bf16(s0 + 2 <= c ? acc[4 * g + 2] : 0.f, s0 + 3 <= c ? acc[4 * g + 3] : 0.f);
                        *(u32x2*)(L + HG_ATT + c * 144 + 2 * s0) = wv;
                    }
                }
                __syncthreads();
#if PROBE_HGRN == 7 && (PROBE_SUB & 2)
                {
                    const int c = tid >> 3, s = (tid & 7) * 8 + (n & 7);
                    float dot = 0.f;
#pragma unroll 1
                    for (int d = 0; d < 128; ++d) dot += bf2f(*(const bf16_t*)(L + HG_QM + c * 272 + 2 * d)) * bf2f(*(const bf16_t*)(L + HG_KM + s * 272 + 2 * d));
                    if (s > c) dot = 0.f;
                    const float al = bf2f(*(const bf16_t*)(L + HG_ATT + c * 144 + 2 * s));
                    if (!(fabsf(al - dot) <= 0.02f * fabsf(dot) + 1e-4f)) atomicAdd((unsigned*)(p.ws + WS_DIFF) + 2, 1u);
                }
#endif
                {
                    const int ct = w >> 2, vt = w & 3;
                    f32x16 acc = zero_acc16();
#pragma unroll
                    for (int kk = 0; kk < 4; ++kk) {
                        const bf16x8 a = *(const bf16x8*)(L + HG_ATT + (ct * 32 + li) * 144 + 2 * (16 * kk + 8 * hh));
                        const bf16x8 bv = *(const bf16x8*)(L + HG_VT + (vt * 32 + li) * 144 + 2 * (16 * kk + 8 * hh));
                        acc = __builtin_amdgcn_mfma_f32_32x32x16_bf16(a, bv, acc, 0, 0, 0);
                    }
#pragma unroll
                    for (int kk = 0; kk < 8; ++kk) {
                        const bf16x8 a = *(const bf16x8*)(L + HG_QM + (ct * 32 + li) * 272 + 2 * (16 * kk + 8 * hh));
                        const bf16x8 bs = *(const bf16x8*)(L + HG_ST + (vt * 32 + li) * 272 + 2 * (16 * kk + 8 * hh));
                        acc = __builtin_amdgcn_mfma_f32_32x32x16_bf16(a, bs, acc, 0, 0, 0);
                    }
                    const int v = vt * 32 + li;
#if PROBE_HGRN == 7 && (PROBE_SUB & 4)
                    {
                        const int r = 5, c = ct * 32 + (r & 3) + 8 * (r >> 2) + 4 * hh;
                        float ref = 0.f;
#pragma unroll 1
                        for (int s = 0; s < 64; ++s) ref += bf2f(*(const bf16_t*)(L + HG_ATT + c * 144 + 2 * s)) * bf2f(*(const bf16_t*)(L + HG_VT + v * 144 + 2 * s));
#pragma unroll 1
                        for (int d = 0; d < 128; ++d) ref += bf2f(*(const bf16_t*)(L + HG_QM + c * 272 + 2 * d)) * bf2f(*(const bf16_t*)(L + HG_ST + v * 272 + 2 * d));
                        if (!(fabsf(acc[r] - ref) <= 0.01f * fabsf(ref) + 1e-3f)) atomicAdd((unsigned*)(p.ws + WS_DIFF) + 3, 1u);
                    }
#endif
#pragma unroll
                    for (int r = 0; r < 16; ++r) {
                        const int c = ct * 32 + (r & 3) + 8 * (r >> 2) + 4 * hh;
                        const int i = 64 * (n - 4) + c; const size_t t = dir ? SEQ - 1 - i : i;
                        O[((size_t)b * SEQ + t) * 512 + h * 128 + v] = (bf16_t)(cvt_pk_bf16(acc[r], 0.f) & 0xffffu);
                    }
                }
            }
            {
                const int dt = w >> 1;
#pragma unroll
                for (int g = 0; g < 4; ++g) {
                    const int d0 = dt * 32 + 8 * g + 4 * hh;
                    const f32x4 a0 = *(const f32x4*)(gsum + d0), a1 = *(const f32x4*)(gsum + 128 + d0), a2 = *(const f32x4*)(gsum + 256 + d0), a3 = *(const f32x4*)(gsum + 384 + d0);
#pragma unroll
                    for (int k = 0; k < 4; ++k) {
                        const float hi = a2[k] + a3[k];
                        const float dec = __expf(a0[k] + a1[k] + hi), eu = __expf(hi);
                        S[0][4 * g + k] = dec * S[0][4 * g + k] + eu * accU0[4 * g + k];
                        S[1][4 * g + k] = dec * S[1][4 * g + k] + eu * accU1[4 * g + k];
                    }
                }
            }
            __syncthreads();
        }
    }
}

__device__ __forceinline__ void phase_hyena_naive(const Params& p, int bid, int nb) {
    const int tid = threadIdx.x;
    float* lds = (float*)g_lds;
    float* Rf = lds;
    float* zb = lds + 4096;
    float* z1 = lds + 4096 + 8192;
    float* sc = lds + 4096 + 16384;
    const bf16_t* U = (const bf16_t*)(p.ws + WS_U);
    const float* filt = (const float*)(p.ws + WS_FILT);
    const float* hn = (const float*)(p.ws + WS_HNORM);
    bf16_t* ymix = (bf16_t*)(p.ws + WS_YMIX);
    for (int u = bid; u < 4096; u += nb) {
        const int c = u >> 3, b0 = (u & 7) * 4;
        if (tid < 128) { const int o = tid >> 6, l = tid & 63; float s = 0.f;
            for (int k = l; k < 256; k += 64) s += hn[(size_t)k * 1024 + o * 512 + c];
            s = wave_sum(s); if (l == 0) sc[o] = 1.0f / s; }
        for (int i = tid; i < 4096; i += NTHREADS) Rf[i] = filt[((size_t)0 * 512 + c) * 4096 + i];
        for (int i = tid; i < 8192; i += NTHREADS) { const int bb = i >> 11, t = i & 2047; zb[i] = bf2f(U[((size_t)(1024 + c) * 32 + b0 + bb) * 2048 + t]); }
        __syncthreads();
#pragma unroll 1
        for (int o = 0; o < 2; ++o) {
            const float* zin = o ? z1 : zb;
            float acc[4][4];
#pragma unroll
            for (int i = 0; i < 4; ++i)
#pragma unroll
                for (int bb = 0; bb < 4; ++bb) acc[i][bb] = 0.f;
            const float* Rb = Rf + 2047 - tid;
#pragma unroll 2
            for (int s = 0; s < 2048; ++s) {
                float r[4], z[4];
#pragma unroll
                for (int i = 0; i < 4; ++i) r[i] = (s - 512 * i + 2047 - tid >= 0) ? Rb[s - 512 * i] : 0.f;
#pragma unroll
                for (int bb = 0; bb < 4; ++bb) z[bb] = zin[bb * 2048 + s];
#pragma unroll
                for (int i = 0; i < 4; ++i)
#pragma unroll
                    for (int bb = 0; bb < 4; ++bb) acc[i][bb] += r[i] * z[bb];
            }
            const float inv = sc[o], dsk = p.hy_d[o * 512 + c];
            if (o == 0) {
#pragma unroll
                for (int i = 0; i < 4; ++i)
#pragma unroll
                    for (int bb = 0; bb < 4; ++bb) { const int t = tid + 512 * i;
                        const float x1 = bf2f(U[((size_t)c * 32 + b0 + bb) * 2048 + t]);
                        z1[bb * 2048 + t] = x1 * (acc[i][bb] * inv + dsk * zb[bb * 2048 + t]); }
                __syncthreads();
                for (int i = tid; i < 4096; i += NTHREADS) Rf[i] = filt[((size_t)1 * 512 + c) * 4096 + i];
                __syncthreads();
            } else {
#pragma unroll
                for (int i = 0; i < 4; ++i)
#pragma unroll
                    for (int bb = 0; bb < 4; ++bb) { const int t = tid + 512 * i;
                        const float x2 = bf2f(U[((size_t)(512 + c) * 32 + b0 + bb) * 2048 + t]);
                        const float y = x2 * (acc[i][bb] * inv + dsk * z1[bb * 2048 + t]);
                        ymix[((size_t)(b0 + bb) * SEQ + t) * 1024 + c] = (bf16_t)(cvt_pk_bf16(y, 0.f) & 0xffffu); }
            }
        }
        __syncthreads();
    }
}

constexpr int HZ_STRIDE = 4112;
constexpr int HZ_F = 32 * HZ_STRIDE;
constexpr int HZ_F1 = 8192 + 64;
constexpr int HZ_SC = HZ_F + 16384 + 128;
__device__ __forceinline__ bf16x8 hy_lda(const unsigned char* q) {
    const unsigned* w = (const unsigned*)q;
    u32x4 v; v.x = w[0]; v.y = w[1]; v.z = w[2]; v.w = w[3];
    return __builtin_bit_cast(bf16x8, v);
}
__device__ __forceinline__ void phase_hyena_mfma(const Params& p, int bid, int nb) {
    const int tid = threadIdx.x, lane = tid & 63, w = tid >> 6, li = lane & 31, hh = lane >> 5;
    unsigned char* Z = g_lds;
    unsigned char* F = g_lds + HZ_F;
    float* sc = (float*)(g_lds + HZ_SC);
    const bf16_t* U = (const bf16_t*)(p.ws + WS_U);
    const float* filt = (const float*)(p.ws + WS_FILT);
    const float* hn = (const float*)(p.ws + WS_HNORM);
    bf16_t* YH = (bf16_t*)(p.ws + WS_YH);
    const int par = (li & 1) ^ 1;
    const unsigned char* fl = F + par * HZ_F1 + 2 * (2047 - li + 8 * hh - par);
    const unsigned char* zl = Z + li * HZ_STRIDE + 16 * hh;
    for (int c = bid; c < 512; c += nb) {
        if (tid < 128) { const int o = tid >> 6, l = tid & 63; float s = 0.f;
            for (int k = l; k < 256; k += 64) s += hn[(size_t)k * 1024 + o * 512 + c];
            s = wave_sum(s); if (l == 0) sc[o] = 1.0f / s; }
        {
            const u32x4* src = (const u32x4*)(U + (size_t)(1024 + c) * 65536);
#pragma unroll
            for (int i = 0; i < 16; ++i) { const int q = tid + 512 * i; *(u32x4*)(Z + (q >> 8) * HZ_STRIDE + (q & 255) * 16) = src[q]; }
        }
#pragma unroll 1
        for (int o = 0; o < 2; ++o) {
            {
                const float* R = filt + ((size_t)o * 512 + c) * 4096;
#pragma unroll
                for (int i = 0; i < 4; ++i) {
                    const int m2 = (tid + 512 * i) * 2;
                    const f32x2 r01 = *(const f32x2*)(R + m2);
                    const float r2 = (m2 + 2 < 4096) ? R[m2 + 2] : 0.f;
                    *(unsigned*)(F + 2 * m2) = cvt_pk_bf16(r01.x, r01.y);
                    *(unsigned*)(F + HZ_F1 + 2 * m2) = cvt_pk_bf16(r01.y, r2);
                }
            }
            __syncthreads();
            const float inv = sc[o], dsk = p.hy_d[o * 512 + c];
            const bf16_t* X = U + ((size_t)(o * 512 + c) * 32 + li) * 2048;
#pragma unroll 1
            for (int pass = 0; pass < 2; ++pass) {
                const int y0 = 8 * w + 4 * pass;
                f32x16 acc[4];
#pragma unroll
                for (int jj = 0; jj < 4; ++jj)
#pragma unroll
                    for (int r = 0; r < 16; ++r) acc[jj][r] = 0.f;
                bf16x8 Ae[4], Ao[4];
#pragma unroll
                for (int jj = 0; jj < 4; ++jj) { Ae[jj] = hy_lda(fl - 64 * (y0 + jj)); Ao[jj] = hy_lda(fl - 64 * (y0 + jj) + 32); }
                const unsigned char* fnext = fl - 64 * (y0 - 1);
                const unsigned char* zp = zl;
#pragma unroll 1
                for (int pp = 0; pp < 16; ++pp) {
#pragma unroll
                    for (int q = 0; q < 4; ++q) {
                        const bf16x8 be = *(const bf16x8*)(zp);
                        const bf16x8 bo = *(const bf16x8*)(zp + 32);
                        zp += 64;
                        __builtin_amdgcn_s_setprio(1);
#pragma unroll
                        for (int jj = 0; jj < 4; ++jj) acc[jj] = __builtin_amdgcn_mfma_f32_32x32x16_bf16(Ae[(jj - q) & 3], be, acc[jj], 0, 0, 0);
                        __builtin_amdgcn_s_setprio(0);
                        Ae[(3 - q) & 3] = hy_lda(fnext);
                        __builtin_amdgcn_s_setprio(1);
#pragma unroll
                        for (int jj = 0; jj < 4; ++jj) acc[jj] = __builtin_amdgcn_mfma_f32_32x32x16_bf16(Ao[(jj - q) & 3], bo, acc[jj], 0, 0, 0);
                        __builtin_amdgcn_s_setprio(0);
                        Ao[(3 - q) & 3] = hy_lda(fnext + 32);
                        fnext += 64;
                    }
                }
#pragma unroll
                for (int jj = 0; jj < 4; ++jj)
#pragma unroll
                    for (int g = 0; g < 4; ++g) {
                        const int t = 32 * (y0 + jj) + 8 * g + 4 * hh;
                        const u32x2 zv = *(const u32x2*)(Z + li * HZ_STRIDE + 2 * t);
                        const u32x2 xv = *(const u32x2*)(X + t);
                        const float o0 = bflo(xv.x) * (acc[jj][4 * g + 0] * inv + dsk * bflo(zv.x));
                        const float o1 = bfhi(xv.x) * (acc[jj][4 * g + 1] * inv + dsk * bfhi(zv.x));
                        const float o2 = bflo(xv.y) * (acc[jj][4 * g + 2] * inv + dsk * bflo(zv.y));
                        const float o3 = bfhi(xv.y) * (acc[jj][4 * g + 3] * inv + dsk * bfhi(zv.y));
                        u32x2 ov; ov.x = cvt_pk_bf16(o0, o1); ov.y = cvt_pk_bf16(o2, o3);
                        *(u32x2*)(YH + ((size_t)c * 32 + li) * 2048 + t) = ov;
                    }
            }
            __threadfence_block();
            __syncthreads();
            if (o == 0) {
                const u32x4* src = (const u32x4*)(YH + (size_t)c * 65536);
#pragma unroll
                for (int i = 0; i < 16; ++i) { const int q = tid + 512 * i; *(u32x4*)(Z + (q >> 8) * HZ_STRIDE + (q & 255) * 16) = src[q]; }
            }
        }
        __syncthreads();
    }
}

__device__ __forceinline__ void tr_bf16_tile(const bf16_t* __restrict__ src, size_t sld, bf16_t* __restrict__ dst, size_t dld) {
    bf16_t* tile = (bf16_t*)g_lds;
    const int t = threadIdx.x;
    {
        const int i = t >> 3, j8 = (t & 7) * 8;
        const u32x4 v = *(const u32x4*)(src + (size_t)i * sld + j8);
        const unsigned wv[4] = {v.x, v.y, v.z, v.w};
#pragma unroll
        for (int e = 0; e < 4; ++e) { tile[(j8 + 2 * e) * 66 + i] = (bf16_t)(wv[e] & 0xffffu); tile[(j8 + 2 * e + 1) * 66 + i] = (bf16_t)(wv[e] >> 16); }
    }
    __syncthreads();
    {
        const int j = t >> 3, i8 = (t & 7) * 8;
        const unsigned* r = (const unsigned*)(tile + j * 66 + i8);
        u32x4 v; v.x = r[0]; v.y = r[1]; v.z = r[2]; v.w = r[3];
        *(u32x4*)(dst + (size_t)j * dld + i8) = v;
    }
    __syncthreads();
}

__device__ __forceinline__ void tr_bf16_tile_f8(const bf16_t* __restrict__ src, size_t sld, unsigned char* __restrict__ dst, size_t dld, float scale) {
    bf16_t* tile = (bf16_t*)g_lds;
    const int t = threadIdx.x;
    {
        const int i = t >> 3, j8 = (t & 7) * 8;
        const u32x4 v = *(const u32x4*)(src + (size_t)i * sld + j8);
        const unsigned wv[4] = {v.x, v.y, v.z, v.w};
#pragma unroll
        for (int e = 0; e < 4; ++e) { tile[(j8 + 2 * e) * 66 + i] = (bf16_t)(wv[e] & 0xffffu); tile[(j8 + 2 * e + 1) * 66 + i] = (bf16_t)(wv[e] >> 16); }
    }
    __syncthreads();
    {
        const int j = t >> 3, i8 = (t & 7) * 8;
        const unsigned* r = (const unsigned*)(tile + j * 66 + i8);
        const unsigned a = r[0], b = r[1], c = r[2], d = r[3];
        u32x2 w;
        w.x = pk_fp8x4(bflo(a) * scale, bfhi(a) * scale, bflo(b) * scale, bfhi(b) * scale);
        w.y = pk_fp8x4(bflo(c) * scale, bfhi(c) * scale, bflo(d) * scale, bfhi(d) * scale);
        *(u32x2*)(dst + (size_t)j * dld + i8) = w;
    }
    __syncthreads();
}

__device__ __forceinline__ void phase_e(const Params& p, int bid, int nb) {
    const int wid = threadIdx.x >> 6, lane = threadIdx.x & 63;
    const bf16_t* O = (const bf16_t*)(p.ws + WS_O);
    const bf16_t* G = (const bf16_t*)(p.ws + WS_G);
    unsigned char* ymix = p.ws + WS_YMIX;
    {
        const f32x4 ng0 = *(const f32x4*)(p.hg_norm_g + ((8 * lane) & 127)), ng1 = *(const f32x4*)(p.hg_norm_g + ((8 * lane) & 127) + 4);
        const float ng[8] = {ng0[0], ng0[1], ng0[2], ng0[3], ng1[0], ng1[1], ng1[2], ng1[3]};
        const int S = nb * 8;
#define E_LOAD(A, B, Gw, TOK) do { if ((TOK) < T) { const size_t ix_ = (size_t)(TOK) * 512 + 8 * lane; \
            A = *(const u32x4*)(O + ix_); B = *(const u32x4*)(O + (size_t)T * 512 + ix_); Gw = *(const u32x4*)(G + ix_); } } while (0)
#define E_DO(A, B, Gw, TOK) do { if ((TOK) < T) { \
            const unsigned av[4] = {A.x, A.y, A.z, A.w}, bv[4] = {B.x, B.y, B.z, B.w}, gv[4] = {Gw.x, Gw.y, Gw.z, Gw.w}; \
            float o[8], ss = 0.f; \
            _Pragma("unroll") for (int e = 0; e < 4; ++e) { o[2 * e] = bflo(av[e]) + bflo(bv[e]); o[2 * e + 1] = bfhi(av[e]) + bfhi(bv[e]); ss += o[2 * e] * o[2 * e] + o[2 * e + 1] * o[2 * e + 1]; } \
            _Pragma("unroll") for (int off = 1; off < 16; off <<= 1) ss += __shfl_xor(ss, off); \
            const float rs = rsqrtf(ss * (1.0f / 128.0f) + EPS) * YMSCALE; \
            float y[8]; \
            _Pragma("unroll") for (int e = 0; e < 4; ++e) { y[2 * e] = o[2 * e] * rs * ng[2 * e] * bflo(gv[e]); y[2 * e + 1] = o[2 * e + 1] * rs * ng[2 * e + 1] * bfhi(gv[e]); } \
            u32x2 w; w.x = pk_fp8x4(y[0], y[1], y[2], y[3]); w.y = pk_fp8x4(y[4], y[5], y[6], y[7]); \
            *(u32x2*)(ymix + (size_t)(TOK) * 1024 + 512 + 8 * lane) = w; } } while (0)
        u32x4 a0 = {}, b0 = {}, g0 = {}, a1 = {}, b1 = {}, g1 = {};
        int tok = bid * 8 + wid;
        E_LOAD(a0, b0, g0, tok); E_LOAD(a1, b1, g1, tok + S);
#pragma unroll 1
        for (; tok < T; tok += 2 * S) {
            u32x4 na0 = {}, nb0 = {}, ng0 = {}, na1 = {}, nb1 = {}, ng1 = {};
            E_LOAD(na0, nb0, ng0, tok + 2 * S); E_LOAD(na1, nb1, ng1, tok + 3 * S);
            E_DO(a0, b0, g0, tok); E_DO(a1, b1, g1, tok + S);
            a0 = na0; b0 = nb0; g0 = ng0; a1 = na1; b1 = nb1; g1 = ng1;
        }
#undef E_LOAD
#undef E_DO
    }
    __syncthreads();
#if !PROBE_HYENA
    {
        const bf16_t* YH = (const bf16_t*)(p.ws + WS_YH);
        const int t = threadIdx.x;
        for (int q0 = bid; q0 < 8192; q0 += 4 * nb) {
            u32x4 v[4];
#pragma unroll
            for (int k = 0; k < 4; ++k) {
                const int q = q0 + k * nb;
                if (q < 8192) { const int ct = q & 7, tt = (q >> 3) & 31, b = q >> 8; const int i = t >> 3, j8 = (t & 7) * 8;
                    v[k] = *(const u32x4*)(YH + ((size_t)(ct * 64 + i) * 32 + b) * 2048 + tt * 64 + j8); }
            }
#pragma unroll
            for (int k = 0; k < 4; ++k) {
                const int q = q0 + k * nb;
                if (q < 8192) { bf16_t* tile = (bf16_t*)g_lds + k * 64 * 66; const int i = t >> 3, j8 = (t & 7) * 8;
                    const unsigned wv[4] = {v[k].x, v[k].y, v[k].z, v[k].w};
#pragma unroll
                    for (int e = 0; e < 4; ++e) { tile[(j8 + 2 * e) * 66 + i] = (bf16_t)(wv[e] & 0xffffu); tile[(j8 + 2 * e + 1) * 66 + i] = (bf16_t)(wv[e] >> 16); } }
            }
            __syncthreads();
#pragma unroll
            for (int k = 0; k < 4; ++k) {
                const int q = q0 + k * nb;
                if (q < 8192) { const int ct = q & 7, tt = (q >> 3) & 31, b = q >> 8; const bf16_t* tile = (const bf16_t*)g_lds + k * 64 * 66;
                    const int j = t >> 3, i8 = (t & 7) * 8;
                    const unsigned* r = (const unsigned*)(tile + j * 66 + i8);
                    const unsigned a = r[0], b2 = r[1], c = r[2], d = r[3];
                    u32x2 w;
                    w.x = pk_fp8x4(bflo(a) * YMSCALE, bfhi(a) * YMSCALE, bflo(b2) * YMSCALE, bfhi(b2) * YMSCALE);
                    w.y = pk_fp8x4(bflo(c) * YMSCALE, bfhi(c) * YMSCALE, bflo(d) * YMSCALE, bfhi(d) * YMSCALE);
                    *(u32x2*)(ymix + ((size_t)b * SEQ + tt * 64 + j) * 1024 + ct * 64 + i8) = w; }
            }
            __syncthreads();
        }
    }
#endif
}

struct EpiOut {
    const Params* p; int pm, pn;
    __device__ __forceinline__ void operator()(f32x4 (&acc)[2][2][4][2], int wr, int wc, int fr, int fq) const {
        const int b = pm >> 3;
        const float* g1 = (const float*)(p->ws + WS_MOD) + (size_t)b * 6144 + 2 * 1024;
        f32x4 gv[2][2];
#pragma unroll
        for (int bj = 0; bj < 2; ++bj)
#pragma unroll
            for (int n = 0; n < 2; ++n) gv[bj][n] = *(const f32x4*)(g1 + pn * 256 + bj * 128 + wc * 32 + 8 * fq + 4 * n);
#pragma unroll
        for (int ai = 0; ai < 2; ++ai) {
            f32x4 xv[4][2][2];
#pragma unroll
            for (int m = 0; m < 4; ++m) {
                const size_t row = (size_t)pm * 256 + ai * 128 + wr * 64 + m * 16 + fr;
#pragma unroll
                for (int bj = 0; bj < 2; ++bj)
#pragma unroll
                    for (int n = 0; n < 2; ++n) xv[m][bj][n] = *(const f32x4*)(p->x + row * 1024 + pn * 256 + bj * 128 + wc * 32 + 8 * fq + 4 * n);
            }
#pragma unroll
            for (int m = 0; m < 4; ++m) {
                const size_t row = (size_t)pm * 256 + ai * 128 + wr * 64 + m * 16 + fr;
#pragma unroll
                for (int bj = 0; bj < 2; ++bj) {
                    const f32x4 o0 = xv[m][bj][0] + gv[bj][0] * acc[ai][bj][m][0], o1 = xv[m][bj][1] + gv[bj][1] * acc[ai][bj][m][1];
                    u32x4 w; w.x = cvt_pk_bf16(o0[0], o0[1]); w.y = cvt_pk_bf16(o0[2], o0[3]); w.z = cvt_pk_bf16(o1[0], o1[1]); w.w = cvt_pk_bf16(o1[2], o1[3]);
                    *(u32x4*)((unsigned char*)p->out + row * 4096 + (pn * 256 + bj * 128 + wc * 32 + 8 * fq) * 2) = w;
                }
            }
        }
    }
};
__device__ __forceinline__ void phase_f(const Params& p, int bid, int nb) {
    const __amdgpu_buffer_rsrc_t ra = G_RSRC(p.ws + WS_YMIX, (size_t)T * 1024);
    const __amdgpu_buffer_rsrc_t rb = G_RSRC(p.ws + WS_WOUT, (size_t)1024 * 1024);
    unsigned av[4]; av[0] = dense_voff(512); av[1] = av[2] = av[3] = 0u;
    const unsigned bv = av[0];
#ifndef REP_F_GEMM
#define REP_F_GEMM 1
#endif
#ifndef REP_F_CONV
#define REP_F_CONV 1
#endif
    {
        struct Src {
            __amdgpu_buffer_rsrc_t ra, rb; unsigned dv; int x, r, R, NX;
            __device__ __forceinline__ bool operator()(int i, GU& u) const {
                const int j = r + R * i;
                if (j >= 1024 / NX) return false;
                const int pm = x + NX * (j >> 2), pn = j & 3;
                u.ra = ra; u.rb = rb; u.av[0] = dv; u.av[1] = u.av[2] = u.av[3] = 0u;
                u.asoff = (unsigned)(pm * 256) * 1024u; u.bsoff = (unsigned)(pn * 256) * 1024u; u.t0 = pm; u.t1 = pn; u.t2 = 0;
                return true;
            }
            __device__ __forceinline__ void after(int) const {}
        } sf;
        const int NX = (nb & 7) == 0 ? 8 : 1;
        sf.ra = ra; sf.rb = rb; sf.dv = bv; sf.NX = NX; sf.x = bid % NX; sf.r = bid / NX; sf.R = nb / NX;
        struct Epi {
            const Params* p;
            __device__ __forceinline__ void operator()(f32x4 (&acc)[2][2][4][2], const GU& u, int wr, int wc, int fr, int fq) const {
                EpiOut e; e.p = p; e.pm = u.t0; e.pn = u.t1; e(acc, wr, wc, fr, fq);
            }
        } ef; ef.p = &p;
        gemm_stream<false, E8_2M5, E8_2M3>(sf, ef, 1024u, 1024u, dense_voff_perm(512), 8);
    }
    __syncthreads();
    unsigned char* W1 = p.ws + WS_W1T; unsigned char* W2 = p.ws + WS_W2T;
#pragma unroll 1
    for (int repc_ = 0; repc_ < REP_F_CONV; ++repc_)
    {
        float* tile = (float*)g_lds;
        const int t = threadIdx.x;
        const int lr = t >> 6, lc4 = (t & 63) * 4;
        auto unit_src = [&](int q, const float*& s, int& C, int& r0, int& c0) {
            const int e = q / 48, tt = q % 48;
            if (tt < 16) { s = e < 256 ? p.ew_gate + (size_t)e * 262144 : p.sw_gate; C = 256; r0 = tt * 64; c0 = 0; }
            else if (tt < 32) { s = e < 256 ? p.ew_up + (size_t)e * 262144 : p.sw_up; C = 256; r0 = (tt - 16) * 64; c0 = 0; }
            else { const int r = tt - 32; s = e < 256 ? p.ew_down + (size_t)e * 262144 : p.sw_down; C = 1024; r0 = (r >> 2) * 64; c0 = (r & 3) * 256; }
        };
        f32x4 v[8];
        int q = bid;
        if (q < 257 * 48) { const float* s; int C, r0, c0; unit_src(q, s, C, r0, c0);
#pragma unroll
            for (int i = 0; i < 8; ++i) v[i] = *(const f32x4*)(s + (size_t)(r0 + lr + 8 * i) * C + c0 + lc4); }
        for (; q < 257 * 48; q += nb) {
#pragma unroll
            for (int i = 0; i < 8; ++i) *(f32x4*)(tile + (lr + 8 * i) * 260 + lc4) = v[i];
            __syncthreads();
            if (q + nb < 257 * 48) { const float* s; int C, r0, c0; unit_src(q + nb, s, C, r0, c0);
#pragma unroll
                for (int i = 0; i < 8; ++i) v[i] = *(const f32x4*)(s + (size_t)(r0 + lr + 8 * i) * C + c0 + lc4); }
            {
                const int e = q / 48, tt = q % 48;
                unsigned char* dst; int dld, r0, c0, add; float scale;
                if (tt < 32) { dst = W1 + (size_t)e * 524288; dld = 1024; r0 = (tt & 15) * 64; c0 = 0; add = (tt < 16) ? 0 : 128; scale = WSCALE; }
                else { const int r = tt - 32; dst = W2 + (size_t)e * 262144; dld = 256; r0 = (r >> 2) * 64; c0 = (r & 3) * 256; add = -1; scale = W2SCALE; }
#pragma unroll
                for (int qq = 0; qq < 4; ++qq) {
                    const int cc = qq * 64 + (t >> 3), rr = (t & 7) * 8;
                    float w8[8];
#pragma unroll
                    for (int k = 0; k < 8; ++k) w8[k] = tile[(rr + k) * 260 + cc] * scale;
                    u32x2 w; w.x = pk_fp8x4(w8[0], w8[1], w8[2], w8[3]); w.y = pk_fp8x4(w8[4], w8[5], w8[6], w8[7]);
                    const int n = c0 + cc;
                    const int drow = add < 0 ? n : (n >> 7) * 256 + add + (n & 127);
                    *(u32x2*)(dst + (size_t)drow * dld + r0 + rr) = w;
                }
            }
            __syncthreads();
        }
    }
}

struct EpiLogits {
    const Params* p; int pm;
    __device__ __forceinline__ void operator()(f32x4 (&acc)[2][2][4][2], int wr, int wc, int fr, int fq) const {
        float* LG = (float*)(p->ws + WS_LG);
#pragma unroll
        for (int ai = 0; ai < 2; ++ai)
#pragma unroll
            for (int m = 0; m < 4; ++m) {
                const size_t row = (size_t)pm * 256 + ai * 128 + wr * 64 + m * 16 + fr;
#pragma unroll
                for (int bj = 0; bj < 2; ++bj)
#pragma unroll
                    for (int n = 0; n < 2; ++n) *(f32x4*)(LG + row * 256 + bj * 128 + wc * 32 + n * 16 + 4 * fq) = acc[ai][bj][m][n];
            }
    }
};
__device__ __forceinline__ float sel4(const float (&a)[4], int j) { return j == 0 ? a[0] : (j == 1 ? a[1] : (j == 2 ? a[2] : a[3])); }
__device__ __forceinline__ void phase_h(const Params& p, int bid, int nb) {
    const __amdgpu_buffer_rsrc_t ra = G_RSRC(p.ws + WS_HX2, (size_t)T * 2048);
    const __amdgpu_buffer_rsrc_t rb = G_RSRC(p.ws + WS_WR, (size_t)256 * 2048);
    const float* LG = (const float*)(p.ws + WS_LG);
    unsigned* cnt = (unsigned*)(p.ws + WS_CNT);
    u32x2* list = (u32x2*)(p.ws + WS_LIST);
    for (int u = bid; u < 256; u += nb) {
        EpiLogits e; e.p = &p; e.pm = u;
        unsigned av[4]; av[0] = dense_voff(1024); av[1] = av[2] = av[3] = 0u;
        gemm_unit<false, false, 0, 0>(ra, av, (unsigned)(u * 256) * 2048u, 2048u, rb, av[0], 0u, 2048u, 16, e);
    }
    __threadfence_block();
    __syncthreads();
    const int wid = threadIdx.x >> 6, lane = threadIdx.x & 63;
    unsigned* lcnt = (unsigned*)g_lds;
    unsigned* lbase = (unsigned*)g_lds + 256;
    unsigned short* lexp = (unsigned short*)(g_lds + 2048);
    unsigned short* lrk = (unsigned short*)(g_lds + 6144);
    float* lw = (float*)(g_lds + 10240);
    for (int u = bid; u < 256; u += nb) {
        if (threadIdx.x < 256) lcnt[threadIdx.x] = 0u;
        __syncthreads();
        const f32x4 rbias = *(const f32x4*)(p.router_bias + 4 * lane);
        f32x4 lgn = *(const f32x4*)(LG + (size_t)(u * 256 + wid * 32) * 256 + 4 * lane);
        for (int rr = 0; rr < 32; ++rr) {
            const int row = u * 256 + wid * 32 + rr;
            const f32x4 lg = lgn;
            if (rr + 1 < 32) lgn = *(const f32x4*)(LG + (size_t)(row + 1) * 256 + 4 * lane);
            float sc[4], val[4];
#pragma unroll
            for (int i = 0; i < 4; ++i) { sc[i] = __builtin_amdgcn_rcpf(1.0f + __expf(-lg[i])); val[i] = sc[i] + rbias[i]; }
            float m1 = -INFINITY, m2 = -INFINITY;
#pragma unroll
            for (int i = 0; i < 4; ++i) { if (val[i] > m1) { m2 = m1; m1 = val[i]; } else if (val[i] > m2) m2 = val[i]; }
#pragma unroll
            for (int off = 1; off < 8; off <<= 1) {
                const float o1 = __shfl_xor(m1, off), o2 = __shfl_xor(m2, off);
                const float n1 = fmaxf(m1, o1), n2 = fmaxf(fminf(m1, o1), fmaxf(m2, o2));
                m1 = n1; m2 = n2;
            }
            const float gs = m1 + m2;
            const int g = lane >> 3;
            int rank = 0;
#pragma unroll
            for (int gg = 0; gg < 8; ++gg) { const float sg = __int_as_float(__builtin_amdgcn_readlane(__float_as_int(gs), gg * 8)); rank += (sg > gs || (sg == gs && gg < g)) ? 1 : 0; }
            unsigned key[4];
#pragma unroll
            for (int i = 0; i < 4; ++i) {
                const unsigned bits = __float_as_uint(val[i]);
                const unsigned mono = bits ^ ((bits >> 31) ? 0xFFFFFFFFu : 0x80000000u);
                key[i] = rank >= 4 ? 0u : ((mono & 0xFFFFFF00u) | (unsigned)(255 - (4 * lane + i)));
            }
            float sumw = 0.f, my_s = 0.f; int my_e = 0;
#pragma unroll
            for (int k = 0; k < 8; ++k) {
                unsigned kb = max(max(key[0], key[1]), max(key[2], key[3]));
#pragma unroll
                for (int off = 32; off > 0; off >>= 1) kb = max(kb, (unsigned)__shfl_xor((int)kb, off));
                const int be = 255 - (int)(kb & 255u);
                const int ol = __builtin_amdgcn_readfirstlane(be >> 2), oj = be & 3;
                const float sk = __int_as_float(__builtin_amdgcn_readlane(__float_as_int(sel4(sc, oj)), ol));
                if (lane == ol) { if (oj == 0) key[0] = 0u; else if (oj == 1) key[1] = 0u; else if (oj == 2) key[2] = 0u; else key[3] = 0u; }
                sumw += sk;
                if (lane == k) { my_e = be; my_s = sk; }
            }
            if (lane < 8) {
                const unsigned lrank = atomicAdd(&lcnt[my_e], 1u);
                const int al = (wid * 32 + rr) * 8 + lane;
                lexp[al] = (unsigned short)my_e; lrk[al] = (unsigned short)lrank;
                lw[al] = 2.5f * my_s / sumw * YSCALE;
            }
        }
        __syncthreads();
        if (threadIdx.x < 256) { const unsigned c = lcnt[threadIdx.x]; lbase[threadIdx.x] = c ? atomicAdd(&cnt[threadIdx.x * 32], c) : 0u; }
        __syncthreads();
#pragma unroll
        for (int i = 0; i < 4; ++i) {
            const int al = threadIdx.x + 512 * i;
            const int e = lexp[al];
            u32x2 ent; ent.x = (unsigned)(u * 2048 + al); ent.y = __float_as_uint(lw[al]);
            list[(size_t)e * 65536 + lbase[e] + lrk[al]] = ent;
        }
        __syncthreads();
    }
}

constexpr int LDS_PRE = 131072;
constexpr int LDS_ROWINFO = 131072 + 2048;
constexpr int LDS_ROWSCALE = 131072 + 4096;
constexpr int LDS_ECNT = 131072 + 6144;
__device__ __forceinline__ int build_tile_prefix(const Params& p) {
    int* pre = (int*)(g_lds + LDS_PRE);
    const unsigned* cnt = (const unsigned*)(p.ws + WS_CNT);
    __syncthreads();
    if (threadIdx.x == 0) {
        int s = 0;
        int* ec = (int*)(g_lds + LDS_ECNT);
        for (int e = 0; e < 256; ++e) { const unsigned c = cnt[e * 32]; ec[e] = (int)c; pre[e] = s; s += (int)((c + 255u) >> 8); }
        pre[256] = s; s += 256; pre[257] = s;
    }
    __syncthreads();
    return pre[257];
}
__device__ __forceinline__ int build_tile_prefix_xcd(const Params& p, int x) {
    int* pre = (int*)(g_lds + LDS_PRE);
    const unsigned* cnt = (const unsigned*)(p.ws + WS_CNT);
    __syncthreads();
    if (threadIdx.x == 0) {
        int s = 0;
        int* ec = (int*)(g_lds + LDS_ECNT);
        for (int k = 0; k < 32; ++k) { const unsigned c = cnt[(x + 8 * k) * 32]; ec[k] = (int)c; pre[k] = s; s += (int)((c + 255u) >> 8); }
        pre[32] = s; pre[33] = s + 32;
    }
    __syncthreads();
    return pre[33];
}
__device__ __forceinline__ void decode_rt_xcd(const Params& p, int x, int rtl, int& e, int& tile, int& cnt_e) {
    const int* pre = (const int*)(g_lds + LDS_PRE);
    if (rtl >= pre[32]) { e = 256; tile = 32 * x + (rtl - pre[32]); cnt_e = T; return; }
    int lo = 0, hi = 31;
    while (lo < hi) { const int mid = (lo + hi + 1) >> 1; if (pre[mid] <= rtl) lo = mid; else hi = mid - 1; }
    e = x + 8 * lo; tile = rtl - pre[lo];
    cnt_e = ((const int*)(g_lds + LDS_ECNT))[lo];
}
__device__ __forceinline__ void decode_rt(const Params& p, int rt, int& e, int& tile, int& cnt_e) {
    const int* pre = (const int*)(g_lds + LDS_PRE);
    int lo = 0, hi = 256;
    while (lo < hi) { const int mid = (lo + hi + 1) >> 1; if (pre[mid] <= rt) lo = mid; else hi = mid - 1; }
    e = lo; tile = rt - pre[lo];
    cnt_e = e < 256 ? ((const int*)(g_lds + LDS_ECNT))[e] : T;
}
__device__ __forceinline__ void load_rowinfo_regs(const Params& p, bool xo, int x, int rt, int& a, float& sc) {
    int e, tile, cnt_e;
    if (xo) decode_rt_xcd(p, x, rt, e, tile, cnt_e); else decode_rt(p, rt, e, tile, cnt_e);
    a = -1; sc = 0.f;
    if (threadIdx.x < 256) {
        const int idx = tile * 256 + threadIdx.x;
        if (idx < cnt_e) {
            if (e < 256) { const u32x2 ent = ((const u32x2*)(p.ws + WS_LIST))[(size_t)e * 65536 + idx]; a = (int)ent.x; sc = __uint_as_float(ent.y); }
            else { a = NA + idx; sc = YSCALE; }
        }
    }
}
__device__ __forceinline__ void store_rowinfo_regs(int a, float sc) {
    __syncthreads();
    if (threadIdx.x < 256) { ((int*)(g_lds + LDS_ROWINFO))[threadIdx.x] = a; ((float*)(g_lds + LDS_ROWSCALE))[threadIdx.x] = sc; }
    __syncthreads();
}
struct EpiE1 {
    const Params* p; int pn;
    __device__ __forceinline__ void operator()(f32x4 (&acc)[2][2][4][2], int wr, int wc, int fr, int fq) const {
        const int* rowinfo = (const int*)(g_lds + LDS_ROWINFO);
        unsigned char* tile = g_lds;
#pragma unroll
        for (int ai = 0; ai < 2; ++ai)
#pragma unroll
            for (int m = 0; m < 4; ++m) {
                const int row = ai * 128 + wr * 64 + m * 16 + fr;
#pragma unroll
                for (int n = 0; n < 2; ++n) {
                    const f32x4 g = acc[ai][0][m][n], uu = acc[ai][1][m][n];
                    *(unsigned*)(tile + row * 144 + wc * 32 + n * 16 + 4 * fq) =
                        pk_fp8x4(siluf_(g[0]) * uu[0] * HSCALE, siluf_(g[1]) * uu[1] * HSCALE, siluf_(g[2]) * uu[2] * HSCALE, siluf_(g[3]) * uu[3] * HSCALE);
                }
            }
        __syncthreads();
        unsigned char* H = p->ws + WS_H;
        int tid = threadIdx.x; asm volatile("" : "+v"(tid));
#pragma unroll
        for (int i = 0; i < 4; ++i) {
            const int idx = tid + 512 * i, row = idx >> 3, ch = idx & 7;
            const int a = rowinfo[row];
            if (a >= 0) *(u32x4*)(H + (size_t)a * 256 + pn * 128 + ch * 16) = *(const u32x4*)(tile + row * 144 + ch * 16);
        }
        __syncthreads();
    }
};
struct EpiE2 {
    const Params* p; int pn;
    __device__ __forceinline__ void operator()(f32x4 (&acc)[2][2][4][2], int wr, int wc, int fr, int fq) const {
        const int* rowinfo = (const int*)(g_lds + LDS_ROWINFO);
        unsigned char* tile = g_lds;
#pragma unroll
        for (int ai = 0; ai < 2; ++ai)
#pragma unroll
            for (int m = 0; m < 4; ++m) {
                const int row = ai * 128 + wr * 64 + m * 16 + fr;
                const float wg = ((const float*)(g_lds + LDS_ROWSCALE))[row];
#pragma unroll
                for (int bj = 0; bj < 2; ++bj)
#pragma unroll
                    for (int n = 0; n < 2; ++n) {
                        const f32x4 v = acc[ai][bj][m][n];
                        *(unsigned*)(tile + row * 272 + bj * 128 + wc * 32 + n * 16 + 4 * fq) = pk_fp8x4(v[0] * wg, v[1] * wg, v[2] * wg, v[3] * wg);
                    }
            }
        __syncthreads();
        int tid = threadIdx.x; asm volatile("" : "+v"(tid));
#pragma unroll
        for (int i = 0; i < 8; ++i) {
            const int idx = tid + 512 * i, row = idx >> 4, ch = idx & 15;
            const int a = rowinfo[row];
            if (a >= 0) {
                unsigned char* dst = a < NA ? p->ws + WS_Y + (size_t)a * 1024 : p->ws + WS_YSH + (size_t)(a - NA) * 1024;
                *(u32x4*)(dst + pn * 256 + ch * 16) = *(const u32x4*)(tile + row * 272 + ch * 16);
            }
        }
        __syncthreads();
    }
};
constexpr int LDS_TAB = 131072 + 2048;
struct SrcI {
    const Params* p; __amdgpu_buffer_rsrc_t ra; bool xo; int x, u0, us, nu, R0, C0, tid, pa;
    __device__ __forceinline__ bool dec(int i, int& e, int& tile, int& cnt_e, int& pn) const {
        const int u = u0 + us * i; if (u >= nu) return false;
        pn = u & 1;
        if (xo) decode_rt_xcd(*p, x, u >> 1, e, tile, cnt_e); else decode_rt(*p, u >> 1, e, tile, cnt_e);
        return true;
    }
    __device__ __forceinline__ void load_pa(int i) {
        int e, tile, cnt_e, pn; pa = -1;
        if (dec(i, e, tile, cnt_e, pn) && tid < 256) {
            const int idx = tile * 256 + tid;
            if (idx < cnt_e) pa = e < 256 ? (int)((const unsigned*)(p->ws + WS_LIST))[((size_t)e * 65536 + idx) * 2] : NA + idx;
        }
    }
    __device__ __forceinline__ void store_tab(int i) const { if (tid < 256) ((int*)(g_lds + LDS_TAB))[(i & 3) * 256 + tid] = pa; }
    __device__ __forceinline__ void after(int j) const { store_tab(j + 3); }
    __device__ __forceinline__ bool operator()(int i, GU& u) {
        int e, tile, cnt_e, pn;
        const bool ok = dec(i, e, tile, cnt_e, pn);
        if (ok) {
            const int* tab = (const int*)(g_lds + LDS_TAB) + (i & 3) * 256;
#pragma unroll
            for (int k = 0; k < 4; ++k) {
                const int a = tab[(k >> 1) * 128 + R0 + 64 * (k & 1)];
                const unsigned tok = a < 0 ? 0u : (a >= NA ? (unsigned)(a - NA) : (unsigned)a >> 3);
                u.av[k] = tok * 1024u + (unsigned)C0 * 2u;
            }
            u.ra = ra; u.rb = G_RSRC(p->ws + WS_W1T + (size_t)e * 524288, 524288);
            u.asoff = 0u; u.bsoff = (unsigned)(pn * 256) * 1024u;
            u.t0 = i & 3; u.t1 = pn; u.t2 = 0;
        }
        if (i > 0) load_pa(i + 2);
        return ok;
    }
};
struct EpiE1S {
    const Params* p;
    __device__ __forceinline__ void operator()(f32x4 (&acc)[2][2][4][2], const GU& u, int wr, int wc, int fr, int fq) const {
        const int* tab = (const int*)(g_lds + LDS_TAB) + u.t0 * 256;
        unsigned char* H = p->ws + WS_H;
        const int pn = u.t1;
#pragma unroll
        for (int ai = 0; ai < 2; ++ai)
#pragma unroll
            for (int m = 0; m < 4; ++m) {
                const int a = tab[ai * 128 + wr * 64 + m * 16 + fr];
                if (a >= 0) {
                    const f32x4 g0 = acc[ai][0][m][0], g1 = acc[ai][0][m][1], u0 = acc[ai][1][m][0], u1 = acc[ai][1][m][1];
                    u32x2 w;
                    w.x = pk_fp8x4(siluf_(g0[0]) * u0[0] * HSCALE, siluf_(g0[1]) * u0[1] * HSCALE, siluf_(g0[2]) * u0[2] * HSCALE, siluf_(g0[3]) * u0[3] * HSCALE);
                    w.y = pk_fp8x4(siluf_(g1[0]) * u1[0] * HSCALE, siluf_(g1[1]) * u1[1] * HSCALE, siluf_(g1[2]) * u1[2] * HSCALE, siluf_(g1[3]) * u1[3] * HSCALE);
                    *(u32x2*)(H + (size_t)a * 256 + pn * 128 + wc * 32 + 8 * fq) = w;
                }
            }
    }
};
__device__ __forceinline__ void phase_i(const Params& p, int bid, int nb) {
    const bool xo = (nb & 7) == 0;
    const int x = bid & 7;
    const int nrt = xo ? build_tile_prefix_xcd(p, x) : build_tile_prefix(p);
    SrcI sf; sf.p = &p; sf.ra = G_RSRC(p.ws + WS_HX2F8, (size_t)T * 1024); sf.xo = xo; sf.x = x;
    sf.u0 = xo ? (bid >> 3) : bid; sf.us = xo ? (nb >> 3) : nb; sf.nu = nrt * 2; sf.tid = threadIdx.x;
    g_thread_rc(sf.R0, sf.C0);
    sf.load_pa(0); sf.store_tab(0); sf.load_pa(1); sf.store_tab(1); sf.load_pa(2); sf.store_tab(2);
    __syncthreads();
    EpiE1S ef; ef.p = &p;
    gemm_stream<true, E8_2M5, E8_1>(sf, ef, 0u, 1024u, dense_voff_perm(512), 8);
    __syncthreads();
}
constexpr int LDS_YSTG = 131072 + 8192;
constexpr size_t WS_DUMP = 512 * 1024;
__device__ __forceinline__ void phase_j(const Params& p, int bid, int nb) {
    const bool xo = (nb & 7) == 0;
    const int x = bid & 7;
    const int nrt = xo ? build_tile_prefix_xcd(p, x) : build_tile_prefix(p);
    const int* rowinfo = (const int*)(g_lds + LDS_ROWINFO);
    const float* rowscale = (const float*)(g_lds + LDS_ROWSCALE);
    bf16_t* shm = (bf16_t*)g_lds;
    constexpr int SCW = E8_2M4, SCA = E8_2M3;
    const __amdgpu_buffer_rsrc_t ra = G_RSRC(p.ws + WS_H, (size_t)(NA + T) * 256);
    const int rt0 = xo ? (bid >> 3) : bid, rts = xo ? (nb >> 3) : nb;
    if (rt0 >= nrt) return;
    int a_n = -1; float sc_n = 0.f;
    load_rowinfo_regs(p, xo, x, rt0, a_n, sc_n);
    store_rowinfo_regs(a_n, sc_n);
    int tz0 = threadIdx.x; asm volatile("" : "+v"(tz0));
    int R0, C0; g_stage_rc(tz0 * 16, R0, C0);
    const int wbase = __builtin_amdgcn_readfirstlane((tz0 >> 6) * 1024);
    const unsigned bv = (unsigned)((64 * (R0 >> 5) + 16 * ((R0 & 15) >> 2) + 4 * ((R0 >> 4) & 1) + (R0 & 3)) * 256 + C0 * 2);
#define J_STAGE_A(tab_) do { _Pragma("unroll") for (int h = 0; h < 2; ++h) { \
            int a0 = rowinfo[(tab_) * 256 + h * 128 + R0], a1 = rowinfo[(tab_) * 256 + h * 128 + R0 + 64]; \
            if (a0 < 0) a0 = 0; if (a1 < 0) a1 = 0; \
            const unsigned v0 = (unsigned)a0 * 256u + (unsigned)C0 * 2u, v1 = (unsigned)a1 * 256u + (unsigned)C0 * 2u; \
            _Pragma("unroll") for (int kt = 0; kt < 2; ++kt) { G_DMA(G_SA(kt, h), ra, v0, (unsigned)kt * 128u); G_DMA((char*)G_SA(kt, h) + 8192, ra, v1, (unsigned)kt * 128u); } } } while (0)
#define J_STAGE_B(rb_, pn_) do { _Pragma("unroll") for (int h = 0; h < 2; ++h) _Pragma("unroll") for (int kt = 0; kt < 2; ++kt) { \
            G_DMA(G_SB(kt, h), rb_, bv, (unsigned)((pn_) * 256 + h * 8) * 256u + (unsigned)kt * 128u); \
            G_DMA((char*)G_SB(kt, h) + 8192, rb_, bv, (unsigned)((pn_) * 256 + h * 8 + 128) * 256u + (unsigned)kt * 128u); } } while (0)
    __amdgpu_buffer_rsrc_t rb;
    { int e, tile, cnt_e; if (xo) decode_rt_xcd(p, x, rt0, e, tile, cnt_e); else decode_rt(p, rt0, e, tile, cnt_e);
      rb = G_RSRC(p.ws + WS_W2T + (size_t)e * 262144, 262144); }
    J_STAGE_A(0); J_STAGE_B(rb, 0);
    if (rt0 + rts < nrt) load_rowinfo_regs(p, xo, x, rt0 + rts, a_n, sc_n);
    int cur = 0;
#pragma unroll 1
    for (int rt = rt0; rt < nrt; rt += rts, cur ^= 1) {
        const bool has_next = rt + rts < nrt;
        __amdgpu_buffer_rsrc_t rbn = rb;
        if (has_next) { int e, tile, cnt_e; if (xo) decode_rt_xcd(p, x, rt + rts, e, tile, cnt_e); else decode_rt(p, rt + rts, e, tile, cnt_e);
                        rbn = G_RSRC(p.ws + WS_W2T + (size_t)e * 262144, 262144); }
        int tz = threadIdx.x; asm volatile("" : "+v"(tz));
        const int wid = tz >> 6, lane = tz & 63, wr = wid >> 2, wc = wid & 3, fr = lane & 15, fq = lane >> 4;
#pragma unroll 1
        for (int pn = 0; pn < 4; ++pn) {
            if (pn == 0 && rt == rt0) asm volatile("s_waitcnt vmcnt(0)" ::: "memory"); else asm volatile("s_waitcnt vmcnt(8)" ::: "memory");
            __syncthreads();
            f32x4 acc[2][2][4][2];
            {
                i32x8 Aa[4], Ba[2], Bb[2];
                G_LDA8(Aa, 0, 0); G_LDB8(Ba, 0, 0); G_LDB8(Bb, 0, 1);
                G_WAIT_L(4); G_SCHED; G_MMA8F(0, 0, Aa, Ba);
                G_WAIT_L(0); G_SCHED; G_MMA8F(0, 1, Aa, Bb); G_SCHED;
                G_LDA8(Aa, 0, 1);
                G_WAIT_L(0); G_SCHED; G_MMA8F(1, 0, Aa, Ba); G_SCHED;
                G_LDB8(Ba, 1, 0);
                G_SCHED; G_MMA8F(1, 1, Aa, Bb); G_SCHED;
                G_LDA8(Aa, 1, 0); G_LDB8(Bb, 1, 1);
                G_WAIT_L(4); G_SCHED; G_MMA8(0, 0, Aa, Ba);
                G_WAIT_L(0); G_SCHED; G_MMA8(0, 1, Aa, Bb); G_SCHED;
                G_LDA8(Aa, 1, 1);
                G_WAIT_L(0); G_SCHED; G_MMA8(1, 0, Aa, Ba); G_MMA8(1, 1, Aa, Bb);
            }
            asm volatile("s_nop 15\n\ts_nop 15" ::: "memory");
            __syncthreads();
            if (pn == 1 && has_next && threadIdx.x < 256) {
                ((int*)(g_lds + LDS_ROWINFO))[(cur ^ 1) * 256 + threadIdx.x] = a_n; ((float*)(g_lds + LDS_ROWSCALE))[(cur ^ 1) * 256 + threadIdx.x] = sc_n;
            }
            if (pn < 3) J_STAGE_B(rb, pn + 1);
            else if (has_next) {
                J_STAGE_A(cur ^ 1); J_STAGE_B(rbn, 0);
                if (rt + 2 * rts < nrt) load_rowinfo_regs(p, xo, x, rt + 2 * rts, a_n, sc_n);
            }
            {
                int ty = threadIdx.x; asm volatile("" : "+v"(ty));
                const int fr_ = ty & 15, fq_ = (ty >> 4) & 3;
#pragma unroll
                for (int ai = 0; ai < 2; ++ai)
#pragma unroll
                    for (int m = 0; m < 4; ++m) {
                        const int row = ai * 128 + wr * 64 + m * 16 + fr_;
                        const float wg = rowscale[cur * 256 + row];
                        const int a = rowinfo[cur * 256 + row];
                        unsigned char* dst = a < 0 ? p.ws + WS_DUMP : (a < NA ? p.ws + WS_Y + (size_t)a * 1024 : p.ws + WS_YSH + (size_t)(a - NA) * 1024);
                        const f32x4 v0 = acc[ai][0][m][0], v1 = acc[ai][0][m][1], v2 = acc[ai][1][m][0], v3 = acc[ai][1][m][1];
                        u32x4 w; w.x = pk_fp8x4(v0[0] * wg, v0[1] * wg, v0[2] * wg, v0[3] * wg); w.y = pk_fp8x4(v1[0] * wg, v1[1] * wg, v1[2] * wg, v1[3] * wg);
                        w.z = pk_fp8x4(v2[0] * wg, v2[1] * wg, v2[2] * wg, v2[3] * wg); w.w = pk_fp8x4(v3[0] * wg, v3[1] * wg, v3[2] * wg, v3[3] * wg);
                        *(u32x4*)(dst + pn * 256 + wc * 64 + 16 * fq_) = w;
                    }
            }
        }
        rb = rbn;
    }
#undef J_STAGE_A
#undef J_STAGE_B
}

__device__ __forceinline__ void phase_k(const Params& p, int bid, int nb) {
    const int wid = threadIdx.x >> 6, lane = threadIdx.x & 63;
    const float* mod = (const float*)(p.ws + WS_MOD);
    for (int tile = bid; tile * 256 < T; tile += nb) {
    const int bt = (tile * 256) >> 11;
    f32x4 g2v[4], fgv[4];
#pragma unroll
    for (int i = 0; i < 4; ++i) { g2v[i] = *(const f32x4*)(mod + (size_t)bt * 6144 + 5 * 1024 + 16 * lane + 4 * i); fgv[i] = *(const f32x4*)(p.final_g + 16 * lane + 4 * i); }
#pragma unroll 1
    for (int kk = 0; kk < 32; ++kk) {
        const int tok = tile * 256 + wid + 8 * kk;
        float s[16];
#pragma unroll
        for (int i = 0; i < 16; ++i) s[i] = 0.f;
#pragma unroll
        for (int k = 0; k < 9; ++k) {
            const unsigned char* src = k < 8 ? p.ws + WS_Y + ((size_t)tok * 8 + k) * 1024 : p.ws + WS_YSH + (size_t)tok * 1024;
            const u32x4 w = *(const u32x4*)(src + 16 * lane);
            acc_fp8x4(w.x, s[0], s[1], s[2], s[3]); acc_fp8x4(w.y, s[4], s[5], s[6], s[7]);
            acc_fp8x4(w.z, s[8], s[9], s[10], s[11]); acc_fp8x4(w.w, s[12], s[13], s[14], s[15]);
        }
        float* xr = p.out + (size_t)tok * 1024 + 16 * lane;
        const u32x4 xb0 = *(const u32x4*)((const unsigned char*)(p.out + (size_t)tok * 1024) + 32 * lane), xb1 = *(const u32x4*)((const unsigned char*)(p.out + (size_t)tok * 1024) + 32 * lane + 16);
        const unsigned xb[8] = {xb0.x, xb0.y, xb0.z, xb0.w, xb1.x, xb1.y, xb1.z, xb1.w};
        f32x4 xv[4]; float ss = 0.f;
#pragma unroll
        for (int i = 0; i < 4; ++i) {
            const f32x4 x1 = (f32x4){__uint_as_float(xb[2 * i] << 16), __uint_as_float(xb[2 * i] & 0xffff0000u), __uint_as_float(xb[2 * i + 1] << 16), __uint_as_float(xb[2 * i + 1] & 0xffff0000u)};
            const f32x4 gv = g2v[i];
#pragma unroll
            for (int j = 0; j < 4; ++j) { const float v = x1[j] + gv[j] * (s[4 * i + j] * (1.0f / YSCALE)); xv[i][j] = v; ss += v * v; }
        }
        ss = wave_sum(ss);
        float rs = rsqrtf(ss * (1.0f / 1024.0f) + EPS);
#if PROBE_HYENA || PROBE_HGRN
        { const unsigned* df = (const unsigned*)(p.ws + WS_DIFF);
          float fac = 1.0f;
#if PROBE_HGRN == 7
          if (df[0] > 100u) fac += 0.5f;
          if (df[1] > 100u) fac += 1.0f;
          if (df[2] > 100u) fac += 2.0f;
          if (df[3] > 100u) fac += 4.0f;
#else
          if (df[0] > 10000u) fac += 0.5f;
          if (df[1] > 335000u) fac += 1.0f;
          if (df[2] > 10000u) fac += 2.0f;
          if (df[3] > 10000u) fac += 4.0f;
#endif
          rs *= fac; }
#endif
#pragma unroll
        for (int i = 0; i < 4; ++i) { *(f32x4*)(xr + 4 * i) = xv[i] * rs * fgv[i]; }
    }
    }
}

__device__ __forceinline__ void probe_trash_lds() {
    __syncthreads();
    for (int i = threadIdx.x; i < (LDS_BYTES - 16) / 4; i += NTHREADS) ((unsigned*)g_lds)[i] = 0xFFFFFFFFu;
    __syncthreads();
}
#if PROBE_HGRN
__device__ __forceinline__ void probe_hgrn_compare(const Params& p, int bid, int nb) {
    const bf16_t* A = (const bf16_t*)(p.ws + WS_O);
    const bf16_t* R = (const bf16_t*)(p.ws + WS_O2);
    unsigned bad[4] = {0u, 0u, 0u, 0u};
    for (size_t i = (size_t)bid * NTHREADS + threadIdx.x; i < (size_t)2 * T * 512; i += (size_t)nb * NTHREADS) {
        const float a = bf2f(A[i]), r = bf2f(R[i]);
        const int dir = (int)(i / ((size_t)T * 512)); const int t = (int)((i / 512) & 2047);
        if (!(fabsf(a - r) <= 0.03f * fabsf(r) + 0.01f)) {
            if (dir == 0 && t < 64) ++bad[0];
            if (dir == 0) ++bad[1];
            if (dir == 1 && t >= 1984) ++bad[2];
            if (dir == 0 && t >= 64 && t < 128) ++bad[3];
        }
    }
#pragma unroll
    for (int k = 0; k < 4; ++k) if (bad[k]) atomicAdd((unsigned*)(p.ws + WS_DIFF) + k, bad[k]);
}
#endif
#if PROBE_HYENA
__device__ __forceinline__ void probe_hyena_compare(const Params& p, int bid, int nb) {
    const bf16_t* YH = (const bf16_t*)(p.ws + WS_YH);
    const bf16_t* ymix = (const bf16_t*)(p.ws + WS_YMIX);
    unsigned bad = 0;
    for (size_t i = (size_t)bid * NTHREADS + threadIdx.x; i < (size_t)512 * 65536; i += (size_t)nb * NTHREADS) {
        const int c = (int)(i >> 16), bt = (int)(i & 65535);
        const float a = bf2f(YH[i]), r = bf2f(ymix[(size_t)bt * 1024 + c]);
        if (!(fabsf(a - r) <= 0.016f * fabsf(r) + 0.004f)) ++bad;
    }
    if (bad) atomicAdd((unsigned*)(p.ws + WS_DIFF), bad);
}
#endif
__device__ __forceinline__ void h_local_sync() {
    asm volatile("s_waitcnt vmcnt(0)" ::: "memory");
    __builtin_amdgcn_fence(__ATOMIC_RELEASE, "workgroup");
    __syncthreads();
    __builtin_amdgcn_fence(__ATOMIC_ACQUIRE, "agent");
}
constexpr int N_PHASES = 10;
__global__ void __launch_bounds__(NTHREADS, 2) fwd_kernel(Params p) {
    const int bid = blockIdx.x, nb = gridDim.x;
    LAS unsigned* xbw = (LAS unsigned*)(g_lds + LDS_BYTES - 16);
    XcdBarrier bar; bar.bar = (unsigned*)(p.ws + WS_BAR); bar.x = 0; bar.st = (volatile LAS unsigned*)xbw;
    const bool multi = (p.ph_hi - p.ph_lo) > 1;
    if (multi) {
        if (threadIdx.x == 0) { xbw[0] = 0u; xbw[1] = 0u; xbw[2] = 0u; xbw[3] = 0u; }
        __syncthreads();
        bar = xcd_barrier_post((unsigned*)(p.ws + WS_BAR), (volatile LAS unsigned*)xbw);
    }
#ifndef REP_PHASE
#define REP_PHASE -1
#endif
#ifndef REP_COUNT
#define REP_COUNT 2
#endif
#define PHASE(i, call) if (p.ph_lo <= (i) && (i) < p.ph_hi) { for (int rep_ = 0; rep_ < ((i) == REP_PHASE ? REP_COUNT : 1); ++rep_) { call; __syncthreads(); } if ((i) + 1 < p.ph_hi) xcd_barrier(bar); }
    PHASE(0, phase_a(p, bid, nb))
    PHASE(1, (norm_rows<1>(p.x, T, p.norm1_g, (const float*)(p.ws + WS_MOD), 0, 1, nullptr, p.ws + WS_HX, BatchLat(), bid, nb),
              norm_rows<1>(p.ctx, TC, p.norm1_g, (const float*)(p.ws + WS_MOD), 0, 1, nullptr, p.ws + WS_HX + (size_t)T * 1024, BatchCtx(), bid, nb)))
    PHASE(2, phase_c(p, bid, nb))
#if PROBE_HYENA == 2
    PHASE(3, (phase_hgrn_mfma(p, bid, nb), phase_hyena_naive(p, bid, nb)))
#elif PROBE_HYENA
    PHASE(3, (phase_hgrn_mfma(p, bid, nb), phase_hyena_naive(p, bid, nb), phase_hyena_mfma(p, bid, nb)))
#elif PROBE_HGRN == 3
    PHASE(3, (phase_hgrn_naive(p, bid, nb, WS_O), phase_hyena_mfma(p, bid, nb)))
#elif PROBE_HGRN == 4 || PROBE_HGRN == 5 || PROBE_HGRN == 6 || PROBE_HGRN == 7
    PHASE(3, (phase_hgrn_naive(p, bid, nb, WS_O), phase_hgrn_mfma(p, bid, nb, WS_O2), phase_hyena_mfma(p, bid, nb)))
#elif PROBE_HGRN == 2
    PHASE(3, (phase_hgrn_mfma(p, bid, nb, WS_O2), probe_trash_lds(), phase_hgrn_mfma(p, bid, nb), phase_hyena_mfma(p, bid, nb)))
#elif PROBE_HGRN
    PHASE(3, (phase_hgrn_naive(p, bid, nb, WS_O2), phase_hgrn_mfma(p, bid, nb), phase_hyena_mfma(p, bid, nb)))
#elif defined(REP_D_HG)
    PHASE(3, (phase_hgrn_mfma(p, bid, nb), __syncthreads(), phase_hgrn_mfma(p, bid, nb), phase_hyena_mfma(p, bid, nb)))
#elif defined(REP_D_HY)
    PHASE(3, (phase_hgrn_mfma(p, bid, nb), phase_hyena_mfma(p, bid, nb), __syncthreads(), phase_hyena_mfma(p, bid, nb)))
#else
    PHASE(3, (phase_hgrn_mfma(p, bid, nb), phase_hyena_mfma(p, bid, nb)))
#endif
#if PROBE_HYENA == 1
    PHASE(4, (probe_hyena_compare(p, bid, nb), phase_e(p, bid, nb)))
#elif PROBE_HGRN == 1 || PROBE_HGRN == 2 || PROBE_HGRN == 5 || PROBE_HGRN == 6
    PHASE(4, (probe_hgrn_compare(p, bid, nb), phase_e(p, bid, nb)))
#else
    PHASE(4, phase_e(p, bid, nb))
#endif
    PHASE(5, phase_f(p, bid, nb))
    PHASE(6, (norm_rows<2>(p.out, T, p.norm2_g, (const float*)(p.ws + WS_MOD), 3, 4, (bf16_t*)(p.ws + WS_HX2), p.ws + WS_HX2F8, BatchLat(), bid, nb),
              h_local_sync(), phase_h(p, bid, nb)))
    PHASE(7, phase_i(p, bid, nb))
    PHASE(8, phase_j(p, bid, nb))
    PHASE(9, phase_k(p, bid, nb))
}

extern "C" void kernel_launch(void* const* d_in, const int* in_sizes, int n_in, void* d_out, int out_size, void* d_ws, size_t ws_size, hipStream_t stream) {
    static int grid = 0;
    if (grid == 0) {
        if (n_in != 30 || out_size != T * D || ws_size < WS_END) { fprintf(stderr, "kernel_launch: unexpected shapes (n_in %d out %d ws %zu need %zu)\n", n_in, out_size, ws_size, (size_t)WS_END); grid = -1; return; }
        int dev = 0, cus = 0, per_cu = 0;
        hipGetDevice(&dev); hipDeviceGetAttribute(&cus, hipDeviceAttributeMultiprocessorCount, dev);
        if (hipFuncSetAttribute((const void*)fwd_kernel, hipFuncAttributeMaxDynamicSharedMemorySize, LDS_BYTES) != hipSuccess) { fprintf(stderr, "kernel_launch: hipFuncSetAttribute failed\n"); grid = -1; return; }
        hipOccupancyMaxActiveBlocksPerMultiprocessor(&per_cu, (const void*)fwd_kernel, NTHREADS, LDS_BYTES);
        (void)hipGetLastError();
        if (per_cu < 1) fprintf(stderr, "kernel_launch: occupancy query says %d blocks per CU\n", per_cu);
        grid = cus > 0 ? cus : 256;
    }
    if (grid < 0) return;
    hipMemsetAsync((char*)d_ws, 0, WS_CTL_BYTES, stream);
    Params p{};
    const float** pp = (const float**)&p;
    for (int i = 0; i < 30; ++i) pp[i] = (const float*)d_in[i];
    p.out = (float*)d_out; p.ws = (unsigned char*)d_ws;
#if N_LAUNCH_SPLIT
    for (int i = 0; i < N_PHASES; ++i) { p.ph_lo = i; p.ph_hi = i + 1; hipLaunchKernelGGL(fwd_kernel, dim3(grid), dim3(NTHREADS), LDS_BYTES, stream, p); }
#else
    p.ph_lo = 0; p.ph_hi = N_PHASES;
    hipLaunchKernelGGL(fwd_kernel, dim3(grid), dim3(NTHREADS), LDS_BYTES, stream, p);
#endif
}
```

```cpp
#include <hip/hip_runtime.h>
#include <stdint.h>
#include <stdio.h>

#ifndef PROBE_HYENA
#define PROBE_HYENA 0
#endif
#ifndef PROBE_HGRN
#define PROBE_HGRN 0
#endif
#ifndef PROBE_SUB
#define PROBE_SUB 32
#endif
#ifndef PROBE_LIMIT
#define PROBE_LIMIT 670000u
#endif
#ifndef N_LAUNCH_SPLIT
#define N_LAUNCH_SPLIT 0
#endif

typedef unsigned short bf16_t;
typedef short bf16x8 __attribute__((ext_vector_type(8)));
typedef float f32x4 __attribute__((ext_vector_type(4)));
typedef float f32x2 __attribute__((ext_vector_type(2)));
typedef float f32x16 __attribute__((ext_vector_type(16)));
typedef unsigned u32x4 __attribute__((ext_vector_type(4)));
typedef unsigned u32x2 __attribute__((ext_vector_type(2)));
typedef _Float16 f16x2 __attribute__((ext_vector_type(2)));
typedef int i32x4 __attribute__((ext_vector_type(4)));
typedef int i32x8 __attribute__((ext_vector_type(8)));

constexpr int D = 1024, NB = 32, SEQ = 2048, T = NB * SEQ, CTX = 256, TC = NB * CTX;
constexpr int INC = 4096, HYW = 512, HGW = 512, NH = 4, HD = 128;
constexpr int NE = 256, TOPK = 8, FF = 256;
constexpr int NA = T * TOPK;
constexpr float EPS = 1e-6f;
constexpr float YSCALE = 16.0f;
constexpr float WSCALE = 32.0f;
constexpr float YMSCALE = 8.0f;
constexpr float HSCALE = 8.0f;
constexpr float W2SCALE = 16.0f;
constexpr int E8_1 = 0x7F7F7F7F, E8_2M5 = 0x7A7A7A7A, E8_2M3 = 0x7C7C7C7C, E8_2M4 = 0x7B7B7B7B;
constexpr int NTHREADS = 512;
constexpr int LDS_BYTES = 160 * 1024;

constexpr size_t MiB = 1ull << 20;
constexpr size_t WS_BAR = 0;
constexpr size_t WS_CNT = 16 * 1024;
constexpr size_t WS_DIFF = 48 * 1024;
constexpr size_t WS_CTL_BYTES = 64 * 1024;
constexpr size_t WS_MOD = 1 * MiB;
constexpr size_t WS_HNORM = 2 * MiB;
constexpr size_t WS_WIN = 4 * MiB;
constexpr size_t WS_WOUT = 12 * MiB;
constexpr size_t WS_WR = 14 * MiB;
constexpr size_t WS_FILT = 16 * MiB;
constexpr size_t WS_LIST = 960 * MiB;
constexpr size_t WS_WSLOT = 96 * MiB;
constexpr size_t WS_HX = 104 * MiB;
constexpr size_t WS_YMIX = 104 * MiB;
constexpr size_t WS_LG = 104 * MiB;
constexpr size_t WS_Y = 104 * MiB;
constexpr size_t WS_YSH = 616 * MiB;
constexpr size_t WS_U = 248 * MiB;
constexpr size_t WS_Q = 440 * MiB;
constexpr size_t WS_LF = 504 * MiB;
constexpr size_t WS_V = 632 * MiB;
constexpr size_t WS_G = 696 * MiB;
constexpr size_t WS_LFC = 760 * MiB;
constexpr size_t WS_VC = 776 * MiB;
constexpr size_t WS_O = 784 * MiB;
constexpr size_t WS_O2 = 912 * MiB;
constexpr size_t WS_YH = 1040 * MiB;
constexpr size_t WS_HX2 = 248 * MiB;
constexpr size_t WS_W1T = 376 * MiB;
constexpr size_t WS_HX2F8 = 505 * MiB;
constexpr size_t WS_W2T = 680 * MiB;
constexpr size_t WS_H = 809 * MiB;
constexpr size_t WS_END = 1104 * MiB;

extern __shared__ __attribute__((aligned(16))) unsigned char g_lds[];

struct Params {
    const float* x; const float* c; const float* ctx; const float* c_ctx; const float* w_mod; const float* b_mod;
    const float* norm1_g; const float* norm2_g; const float* w_in; const float* w_out; const float* hy_conv_w; const float* hy_conv_b;
    const float* fw1; const float* fb1; const float* fw2; const float* fb2; const float* fw3; const float* freq; const float* hy_d;
    const float* lb_logits; const float* hg_norm_g; const float* w_router; const float* router_bias;
    const float* ew_gate; const float* ew_up; const float* ew_down; const float* sw_gate; const float* sw_up; const float* sw_down; const float* final_g;
    float* out; unsigned char* ws; int ph_lo, ph_hi;
};

typedef __bf16 bf16v2_t __attribute__((ext_vector_type(2)));
__device__ __forceinline__ unsigned cvt_pk_bf16(float lo, float hi) { const f32x2 v = {lo, hi}; return __builtin_bit_cast(unsigned, __builtin_convertvector(v, bf16v2_t)); }
__device__ __forceinline__ float bf2f(unsigned short h) { return __uint_as_float((unsigned)h << 16); }
__device__ __forceinline__ float bflo(unsigned w) { return __uint_as_float(w << 16); }
__device__ __forceinline__ float bfhi(unsigned w) { return __uint_as_float(w & 0xffff0000u); }
__device__ __forceinline__ float sigmoidf_(float v) { return __builtin_amdgcn_rcpf(1.0f + __expf(-v)); }
__device__ __forceinline__ float siluf_(float v) { return v * __builtin_amdgcn_rcpf(1.0f + __expf(-v)); }
__device__ __forceinline__ float wave_sum(float v) {
#pragma unroll
    for (int o = 32; o > 0; o >>= 1) v += __shfl_xor(v, o);
    return v;
}
__device__ __forceinline__ unsigned pk_fp8x4(float a, float b, float c, float d) {
    a = fminf(fmaxf(a, -448.f), 448.f); b = fminf(fmaxf(b, -448.f), 448.f); c = fminf(fmaxf(c, -448.f), 448.f); d = fminf(fmaxf(d, -448.f), 448.f);
    int p = __builtin_amdgcn_cvt_pk_fp8_f32(a, b, 0, false);
    p = __builtin_amdgcn_cvt_pk_fp8_f32(c, d, p, true);
    return (unsigned)p;
}
__device__ __forceinline__ void acc_fp8x4(unsigned w, float& a, float& b, float& c, float& d) {
    f32x2 lo = __builtin_amdgcn_cvt_pk_f32_fp8((int)w, false), hi = __builtin_amdgcn_cvt_pk_f32_fp8((int)w, true);
    a += lo.x; b += lo.y; c += hi.x; d += hi.y;
}

#define XB_TMO      128
#define XB_XCNT(j)  (256  + 64 * (j))
#define XB_XSUB(j)  (1280 + 64 * (j))
#define XB_XGEN(j)  (2304 + 64 * (j))
#define XB_TOP      3328
#define XB_TOPGEN   3392
#define XCD_BAR_WORDS 3456
#define XB_SPIN_CAP (1u << 22)
#define LAS __attribute__((address_space(3)))
__device__ __forceinline__ unsigned xb_ld(unsigned* p)              { return __hip_atomic_load(p, __ATOMIC_RELAXED, __HIP_MEMORY_SCOPE_AGENT); }
__device__ __forceinline__ unsigned xb_add(unsigned* p, unsigned v) { return __hip_atomic_fetch_add(p, v, __ATOMIC_RELAXED, __HIP_MEMORY_SCOPE_AGENT); }
__device__ __forceinline__ unsigned xb_xcc_id() { return (unsigned)__builtin_amdgcn_s_getreg((3 << 11) | 20) & 0xFu; }
#define XB_SPIN(cond, bar) do { unsigned _sp = 0; while (cond) { __builtin_amdgcn_s_sleep(1); \
    if ((++_sp & 255u) == 0u) { if (xb_ld(&(bar)[XB_TMO])) break; if (_sp > XB_SPIN_CAP) { atomicAdd(&(bar)[XB_TMO], 1u); break; } } } } while (0)
struct XcdBarrier { unsigned* bar; unsigned x; volatile LAS unsigned* st; };
__device__ __forceinline__ XcdBarrier xcd_barrier_post(unsigned* bar, volatile LAS unsigned* st) {
    XcdBarrier b; b.bar = bar; b.x = xb_xcc_id(); b.st = st;
    if (threadIdx.x == 0) (void)xb_add(&bar[XB_XCNT(b.x)], 1u);
    return b;
}
__device__ __forceinline__ void xcd_barrier_complete(unsigned* bar, unsigned x, unsigned& nloc, unsigned& nx) {
    const unsigned G = gridDim.x * gridDim.y * gridDim.z;
    unsigned sum, cnt, mine, sp = 0u;
    for (;;) {
        sum = 0u; cnt = 0u; mine = 0u;
#pragma unroll
        for (unsigned j = 0; j < 16; ++j) { const unsigned c = xb_ld(&bar[XB_XCNT(j)]); sum += c; cnt += (c > 0u) ? 1u : 0u; mine = (j == x) ? c : mine; }
        if (sum == G) break;
        __builtin_amdgcn_s_sleep(1);
        if ((++sp & 255u) == 0u) { if (xb_ld(&bar[XB_TMO])) break; if (sp > XB_SPIN_CAP) { atomicAdd(&bar[XB_TMO], 1u); break; } }
    }
    nloc = mine > 0u ? mine : 1u; nx = cnt > 0u ? cnt : 1u;
}
__device__ __forceinline__ void xcd_barrier(const XcdBarrier& b) {
    asm volatile("s_waitcnt vmcnt(0)" ::: "memory");
    __syncthreads();
    if (threadIdx.x == 0) {
        unsigned* bar = b.bar;
        __builtin_amdgcn_s_waitcnt(0);
        unsigned nloc = b.st[0], nx = b.st[1];
        if (nloc == 0u) { xcd_barrier_complete(bar, b.x, nloc, nx); b.st[0] = nloc; b.st[1] = nx; }
        const unsigned old = xb_add(&bar[XB_XSUB(b.x)], 1u);
        const unsigned gen = old / nloc;
        if (old + 1u == (gen + 1u) * nloc) {
            __builtin_amdgcn_fence(__ATOMIC_RELEASE, "agent");
            asm volatile("s_waitcnt vmcnt(0)" ::: "memory");
            const unsigned og = xb_add(&bar[XB_TOP], 1u);
            const unsigned tg = og / nx;
            if (og + 1u == (tg + 1u) * nx) xb_add(&bar[XB_TOPGEN], 1u);
            else XB_SPIN(xb_ld(&bar[XB_TOPGEN]) == tg, bar);
            __builtin_amdgcn_fence(__ATOMIC_ACQUIRE, "agent");
            xb_add(&bar[XB_XGEN(b.x)], 1u);
            asm volatile("s_waitcnt vmcnt(0)" ::: "memory");
        } else {
            XB_SPIN(xb_ld(&bar[XB_XGEN(b.x)]) == gen, bar);
            __builtin_amdgcn_fence(__ATOMIC_ACQUIRE, "agent");
            asm volatile("s_waitcnt vmcnt(0)" ::: "memory");
        }
    }
    __syncthreads();
}

constexpr int G_HT = 128 * 64;
__device__ __forceinline__ int g_lds_byte(int r, int c) {
    int st = (r >> 4) * 2 + (c >> 5), rr = r & 15, cc = c & 31, ob = rr * 64 + cc * 2;
    return st * 1024 + (ob ^ (((ob >> 9) & 1) << 5));
}
__device__ __forceinline__ void g_stage_rc(int b, int& R, int& C) {
    int st = b / 1024, sb = b % 1024, swz = sb ^ (((sb >> 9) & 1) << 5);
    R = (st >> 1) * 16 + swz / 64; C = (st & 1) * 32 + (swz % 64) / 2;
}
__device__ __forceinline__ void g_thread_rc(int& R0, int& C0) { g_stage_rc((int)threadIdx.x * 16, R0, C0); }

#define G_SA(b, h) (shm + ((b) * 2 + (h)) * G_HT)
#define G_SB(b, h) (shm + (4 + (b) * 2 + (h)) * G_HT)
#define G_RSRC(ptr, bytes) __builtin_amdgcn_make_buffer_rsrc((void*)(ptr), (short)0, (int)(bytes), 0x00020000)
#define G_DMA(P, RS, VO, SO) __builtin_amdgcn_raw_ptr_buffer_load_lds(RS, (LAS void*)((char*)(P) + wbase), 16, (int)(VO), (int)(SO), 0, 0)
#define G_STAGE_A(P, h, kt) do { \
    if (GATHER) { G_DMA(P, ra, av[(h) * 2 + 0], (unsigned)(kt) * 128u); G_DMA((char*)(P) + 8192, ra, av[(h) * 2 + 1], (unsigned)(kt) * 128u); } \
    else { G_DMA(P, ra, av[0], asoff + (unsigned)((h) * 128) * ald + (unsigned)(kt) * 128u); G_DMA((char*)(P) + 8192, ra, av[0], asoff + (unsigned)((h) * 128 + 64) * ald + (unsigned)(kt) * 128u); } } while (0)
#define G_STAGE_B(P, h, kt) do { \
    G_DMA(P, rb, bv, bsoff + (unsigned)((h) * BHS) * bld + (unsigned)(kt) * 128u); G_DMA((char*)(P) + 8192, rb, bv, bsoff + (unsigned)((h) * BHS + BPS) * bld + (unsigned)(kt) * 128u); } while (0)
#define G_LDA(dst, b, h) for (int m = 0; m < 4; ++m) for (int k = 0; k < 2; ++k) \
    dst[m][k] = *reinterpret_cast<const bf16x8*>((char*)G_SA(b, h) + g_lds_byte(wr * 64 + m * 16 + fr, k * 32 + fq * 8))
#define G_LDB(dst, b, h) for (int n = 0; n < 2; ++n) for (int k = 0; k < 2; ++k) \
    dst[n][k] = *reinterpret_cast<const bf16x8*>((char*)G_SB(b, h) + g_lds_byte(wc * 32 + n * 16 + fr, k * 32 + fq * 8))
#define G_MMA(ai, bj, At, Bt) do { __builtin_amdgcn_s_setprio(1); \
    for (int m = 0; m < 4; ++m) for (int n = 0; n < 2; ++n) for (int k = 0; k < 2; ++k) \
      acc[ai][bj][m][n] = __builtin_amdgcn_mfma_f32_16x16x32_bf16(Bt[n][k], At[m][k], acc[ai][bj][m][n], 0, 0, 0); \
    __builtin_amdgcn_s_setprio(0); } while (0)
#define G_LDA8(dst, b, h) _Pragma("unroll") for (int m = 0; m < 4; ++m) { \
    const i32x4 lo_ = *reinterpret_cast<const i32x4*>((char*)G_SA(b, h) + g_lds_byte(wr * 64 + m * 16 + fr, fq * 8)); \
    const i32x4 hi_ = *reinterpret_cast<const i32x4*>((char*)G_SA(b, h) + g_lds_byte(wr * 64 + m * 16 + fr, 32 + fq * 8)); \
    dst[m] = (i32x8){lo_.x, lo_.y, lo_.z, lo_.w, hi_.x, hi_.y, hi_.z, hi_.w}; }
#define G_LDB8(dst, b, h) _Pragma("unroll") for (int n = 0; n < 2; ++n) { \
    const i32x4 lo_ = *reinterpret_cast<const i32x4*>((char*)G_SB(b, h) + g_lds_byte(wc * 32 + n * 16 + fr, fq * 8)); \
    const i32x4 hi_ = *reinterpret_cast<const i32x4*>((char*)G_SB(b, h) + g_lds_byte(wc * 32 + n * 16 + fr, 32 + fq * 8)); \
    dst[n] = (i32x8){lo_.x, lo_.y, lo_.z, lo_.w, hi_.x, hi_.y, hi_.z, hi_.w}; }
__device__ __forceinline__ void mfma8_tied(f32x4& c, const i32x8& a, const i32x8& b, int sa, int sb) {
    asm volatile("v_mfma_scale_f32_16x16x128_f8f6f4 %0, %1, %2, %0, %3, %4 op_sel_hi:[0,0,0]" : "+v"(c) : "v"(a), "v"(b), "v"(sa), "v"(sb));
}
__device__ __forceinline__ void mfma8_first(f32x4& c, const i32x8& a, const i32x8& b, int sa, int sb) {
    asm volatile("v_mfma_scale_f32_16x16x128_f8f6f4 %0, %1, %2, 0, %3, %4 op_sel_hi:[0,0,0]" : "=&v"(c) : "v"(a), "v"(b), "v"(sa), "v"(sb));
}
#define G_MMA8F(ai, bj, At, Bt) do { __builtin_amdgcn_s_setprio(1); \
    _Pragma("unroll") for (int m = 0; m < 4; ++m) _Pragma("unroll") for (int n = 0; n < 2; ++n) \
      mfma8_first(acc[ai][bj][m][n], Bt[n], At[m], SCW, SCA); \
    __builtin_amdgcn_s_setprio(0); } while (0)
#define G_MMA8(ai, bj, At, Bt) do { __builtin_amdgcn_s_setprio(1); \
    _Pragma("unroll") for (int m = 0; m < 4; ++m) _Pragma("unroll") for (int n = 0; n < 2; ++n) \
      mfma8_tied(acc[ai][bj][m][n], Bt[n], At[m], SCW, SCA); \
    __builtin_amdgcn_s_setprio(0); } while (0)
#define G_WAIT_V(n) asm volatile("s_waitcnt vmcnt(" #n ")" ::: "memory")
#define G_WAIT_L(n) asm volatile("s_waitcnt lgkmcnt(" #n ")" ::: "memory")
#define G_BAR __builtin_amdgcn_s_barrier()
#define G_SCHED __builtin_amdgcn_sched_barrier(0)

#define G_KLOOP(LDA_, LDB_, MMA_) \
    G_STAGE_B(G_SB(0, 0), 0, 0); G_STAGE_A(G_SA(0, 0), 0, 0); \
    G_STAGE_B(G_SB(0, 1), 1, 0); G_STAGE_A(G_SA(0, 1), 1, 0); \
    if (wr == 1) G_BAR; \
    G_WAIT_V(4); G_BAR; \
    G_STAGE_B(G_SB(1, 0), 0, 1); G_STAGE_A(G_SA(1, 0), 0, 1); G_STAGE_B(G_SB(1, 1), 1, 1); \
    G_WAIT_V(6); G_BAR; \
    for (int t = 0; t < nt - 2; t += 2) { \
        LDB_(B0, 0, 0); G_SCHED; LDA_(At, 0, 0); G_STAGE_A(G_SA(1, 1), 1, t + 1); \
        G_WAIT_L(8); G_BAR; MMA_(0, 0, At, B0); G_BAR; G_SCHED; \
        LDB_(B1, 0, 1); G_STAGE_B(G_SB(0, 0), 0, t + 2); \
        G_BAR; MMA_(0, 1, At, B1); G_BAR; \
        LDA_(At, 0, 1); G_STAGE_A(G_SA(0, 0), 0, t + 2); \
        G_BAR; MMA_(1, 0, At, B0); G_BAR; G_SCHED; \
        G_STAGE_B(G_SB(0, 1), 1, t + 2); \
        G_WAIT_V(6); G_BAR; MMA_(1, 1, At, B1); G_BAR; \
        LDB_(B0, 1, 0); G_SCHED; LDA_(At, 1, 0); G_STAGE_A(G_SA(0, 1), 1, t + 2); \
        G_WAIT_L(8); G_BAR; MMA_(0, 0, At, B0); G_BAR; G_SCHED; \
        LDB_(B1, 1, 1); G_STAGE_B(G_SB(1, 0), 0, t + 3); \
        G_BAR; MMA_(0, 1, At, B1); G_BAR; \
        LDA_(At, 1, 1); G_STAGE_A(G_SA(1, 0), 0, t + 3); \
        G_BAR; MMA_(1, 0, At, B0); G_BAR; G_SCHED; \
        G_STAGE_B(G_SB(1, 1), 1, t + 3); \
        G_WAIT_V(6); G_BAR; MMA_(1, 1, At, B1); G_BAR; \
    } \
    asm volatile("" : "+v"(tz)); wid = tz >> 6; lane = tz & 63; wr = wid >> 2; wc = wid & 3; fr = lane & 15; fq = lane >> 4; \
    { LDB_(B0, 0, 0); G_WAIT_V(0); LDA_(At, 0, 0); G_STAGE_A(G_SA(1, 1), 1, nt - 1); \
      G_BAR; G_WAIT_L(0); MMA_(0, 0, At, B0); G_BAR; \
      LDB_(B1, 0, 1); G_BAR; G_WAIT_L(0); MMA_(0, 1, At, B1); G_BAR; \
      LDA_(At, 0, 1); G_WAIT_V(4); G_BAR; G_WAIT_L(0); MMA_(1, 0, At, B0); MMA_(1, 1, At, B1); G_BAR; } \
    { LDB_(B0, 1, 0); LDA_(At, 1, 0); G_WAIT_V(2); G_BAR; G_WAIT_L(0); MMA_(0, 0, At, B0); G_BAR; \
      LDB_(B1, 1, 1); G_WAIT_V(0); G_BAR; G_WAIT_L(0); MMA_(0, 1, At, B1); G_BAR; \
      LDA_(At, 1, 1); G_BAR; G_WAIT_L(0); MMA_(1, 0, At, B0); MMA_(1, 1, At, B1); G_BAR; } \
    if (wr == 0) G_BAR;

template <bool GATHER, bool F8, int SCW, int SCA, int BHS, int BPS, class EPI>
__device__ __forceinline__ void gemm_unit_x(__amdgpu_buffer_rsrc_t ra, const unsigned (&av)[4], const unsigned asoff, const unsigned ald,
                                          __amdgpu_buffer_rsrc_t rb, const unsigned bv, const unsigned bsoff, const unsigned bld, const int nt_in, EPI& epi) {
    bf16_t* shm = (bf16_t*)g_lds;
    int tz = threadIdx.x;
    int wid = tz >> 6, lane = tz & 63, wr = wid >> 2, wc = wid & 3, fr = lane & 15, fq = lane >> 4;
    const int wbase = __builtin_amdgcn_readfirstlane(wid * 1024);
    f32x4 acc[2][2][4][2] = {};
    int nt = nt_in; asm volatile("" : "+s"(nt));
    if constexpr (F8) {
        i32x8 At[4], B0[2], B1[2];
        G_KLOOP(G_LDA8, G_LDB8, G_MMA8)
        asm volatile("s_nop 15\n\ts_nop 15" ::: "memory");
    } else {
        bf16x8 At[4][2], B0[2][2], B1[2][2];
        G_KLOOP(G_LDA, G_LDB, G_MMA)
    }
    epi(acc, wr, wc, fr, fq);
}
template <bool GATHER, bool F8, int SCW, int SCA, class EPI>
__device__ __forceinline__ void gemm_unit(__amdgpu_buffer_rsrc_t ra, const unsigned (&av)[4], const unsigned asoff, const unsigned ald,
                                          __amdgpu_buffer_rsrc_t rb, const unsigned bv, const unsigned bsoff, const unsigned bld, const int nt_in, EPI& epi) {
    gemm_unit_x<GATHER, F8, SCW, SCA, 128, 64, EPI>(ra, av, asoff, ald, rb, bv, bsoff, bld, nt_in, epi);
}

struct GU {
    __amdgpu_buffer_rsrc_t ra, rb;
    unsigned av[4];
    unsigned asoff, bsoff;
    int t0, t1, t2;
};
#define S_STAGE_A(P, U, h, kt) do { \
    if (GATHER) { G_DMA(P, U##ra, ((h) ? U##a2 : U##a0), (unsigned)(kt) * 128u); G_DMA((char*)(P) + 8192, U##ra, ((h) ? U##a3 : U##a1), (unsigned)(kt) * 128u); } \
    else { G_DMA(P, U##ra, U##a0, U##aso + (unsigned)((h) * 128) * ald + (unsigned)(kt) * 128u); \
           G_DMA((char*)(P) + 8192, U##ra, U##a0, U##aso + (unsigned)((h) * 128 + 64) * ald + (unsigned)(kt) * 128u); } } while (0)
#define S_STAGE_B(P, U, h, kt) do { \
    G_DMA(P, U##rb, bv, U##bso + (unsigned)((h) * 128) * bld + (unsigned)(kt) * 128u); \
    G_DMA((char*)(P) + 8192, U##rb, bv, U##bso + (unsigned)((h) * 128 + 64) * bld + (unsigned)(kt) * 128u); } while (0)
#define S_LOAD(U, G) do { U##ra = (G).ra; U##rb = (G).rb; U##a0 = (G).av[0]; U##a1 = (G).av[1]; U##a2 = (G).av[2]; U##a3 = (G).av[3]; U##aso = (G).asoff; U##bso = (G).bsoff; } while (0)
template <bool GATHER, int SCW, int SCA, class SRC, class EPI>
__device__ __forceinline__ void gemm_stream(SRC& srcf, EPI& epi, const unsigned ald, const unsigned bld, const unsigned bv, const int nt_in) {
    bf16_t* shm = (bf16_t*)g_lds;
    int tz = threadIdx.x;
    int wid = tz >> 6, lane = tz & 63, wr = wid >> 2, wc = wid & 3, fr = lane & 15, fq = lane >> 4;
    const int wbase = __builtin_amdgcn_readfirstlane(wid * 1024);
    int nt = nt_in; asm volatile("" : "+s"(nt));
    GU cu, nx; int ui = 0;
    if (!srcf(0, cu)) return;
    __amdgpu_buffer_rsrc_t c_ra, c_rb, n_ra, n_rb, s_ra, s_rb;
    unsigned c_a0, c_a1, c_a2, c_a3, c_aso, c_bso, n_a0, n_a1, n_a2, n_a3, n_aso, n_bso, s_a0, s_a1, s_a2, s_a3, s_aso, s_bso;
    S_LOAD(c_, cu);
    f32x4 acc[2][2][4][2];
#pragma unroll
    for (int a_ = 0; a_ < 2; ++a_)
#pragma unroll
        for (int b_ = 0; b_ < 2; ++b_)
#pragma unroll
            for (int m_ = 0; m_ < 4; ++m_)
#pragma unroll
                for (int n_ = 0; n_ < 2; ++n_) acc[a_][b_][m_][n_] = (f32x4){0.f, 0.f, 0.f, 0.f};
    i32x8 At[4], B0[2], B1[2];
    S_STAGE_B(G_SB(0, 0), c_, 0, 0); S_STAGE_A(G_SA(0, 0), c_, 0, 0); S_STAGE_B(G_SB(0, 1), c_, 1, 0); S_STAGE_A(G_SA(0, 1), c_, 1, 0);
    if (wr == 1) G_BAR;
    G_WAIT_V(4); G_BAR;
    S_STAGE_B(G_SB(1, 0), c_, 0, 1); S_STAGE_A(G_SA(1, 0), c_, 0, 1); S_STAGE_B(G_SB(1, 1), c_, 1, 1);
    G_WAIT_V(6); G_BAR;
#pragma unroll 1
    for (;;) {
        const bool has_next = srcf(ui + 1, nx);
        if (has_next) { S_LOAD(n_, nx); }
        else { n_ra = c_ra; n_rb = c_rb; n_a0 = c_a0; n_a1 = c_a1; n_a2 = c_a2; n_a3 = c_a3; n_aso = c_aso; n_bso = c_bso; }
#pragma unroll 1
        for (int t = 0; t < nt; t += 2) {
            const bool last = (t == nt - 2);
            s_ra = last ? n_ra : c_ra; s_rb = last ? n_rb : c_rb; s_a0 = last ? n_a0 : c_a0; s_a1 = last ? n_a1 : c_a1; s_a2 = last ? n_a2 : c_a2; s_a3 = last ? n_a3 : c_a3;
            s_aso = last ? n_aso : c_aso; s_bso = last ? n_bso : c_bso;
            const int k2 = last ? 0 : t + 2;
            G_LDB8(B0, 0, 0); G_SCHED; G_LDA8(At, 0, 0); S_STAGE_A(G_SA(1, 1), c_, 1, t + 1);
            G_WAIT_L(8); G_BAR; G_MMA8(0, 0, At, B0); G_BAR; G_SCHED;
            G_LDB8(B1, 0, 1); S_STAGE_B(G_SB(0, 0), s_, 0, k2);
            G_BAR; G_MMA8(0, 1, At, B1); G_BAR;
            G_LDA8(At, 0, 1); S_STAGE_A(G_SA(0, 0), s_, 0, k2);
            G_BAR; G_MMA8(1, 0, At, B0); G_BAR; G_SCHED;
            S_STAGE_B(G_SB(0, 1), s_, 1, k2);
            G_WAIT_V(6); G_BAR; G_MMA8(1, 1, At, B1); G_BAR;
            G_LDB8(B0, 1, 0); G_SCHED; G_LDA8(At, 1, 0); S_STAGE_A(G_SA(0, 1), s_, 1, k2);
            G_WAIT_L(8); G_BAR; G_MMA8(0, 0, At, B0); G_BAR; G_SCHED;
            G_LDB8(B1, 1, 1); S_STAGE_B(G_SB(1, 0), s_, 0, k2 + 1);
            G_BAR; G_MMA8(0, 1, At, B1); G_BAR;
            G_LDA8(At, 1, 1); S_STAGE_A(G_SA(1, 0), s_, 0, k2 + 1);
            G_BAR; G_MMA8(1, 0, At, B0); G_BAR; G_SCHED;
            S_STAGE_B(G_SB(1, 1), s_, 1, k2 + 1);
            G_WAIT_V(6); G_BAR; G_MMA8(1, 1, At, B1); G_BAR;
        }
        asm volatile("s_nop 15\n\ts_nop 15" ::: "memory");
        epi(acc, cu, wr, wc, fr, fq);
        srcf.after(ui);
        if (!has_next) break;
#pragma unroll
        for (int a_ = 0; a_ < 2; ++a_)
#pragma unroll
            for (int b_ = 0; b_ < 2; ++b_)
#pragma unroll
                for (int m_ = 0; m_ < 4; ++m_)
#pragma unroll
                    for (int n_ = 0; n_ < 2; ++n_) acc[a_][b_][m_][n_] = (f32x4){0.f, 0.f, 0.f, 0.f};
        cu = nx; S_LOAD(c_, cu); ++ui;
    }
    G_WAIT_V(0);
    if (wr == 0) G_BAR;
    G_BAR;
}
__device__ __forceinline__ int perm32(int rho) { const int n = rho >> 4, i = rho & 15; return 8 * (i >> 2) + 4 * n + (i & 3); }
__device__ __forceinline__ unsigned dense_voff_perm(int ld) { int R0, C0; g_thread_rc(R0, C0); const int Rp = (R0 & ~31) + perm32(R0 & 31); return (unsigned)(Rp * ld + C0) * 2u; }

__device__ __forceinline__ unsigned dense_voff(int ld) { int R0, C0; g_thread_rc(R0, C0); return (unsigned)(R0 * ld + C0) * 2u; }

template <class RM>
__device__ __forceinline__ void tcvt_tile(const float* __restrict__ src, int C, int r0, int c0, bf16_t* __restrict__ dst, int dld, RM rm) {
    float* tile = (float*)g_lds;
    const int t = threadIdx.x;
    {
        const int r = t >> 4, c4 = (t & 15) * 4;
#pragma unroll
        for (int i = 0; i < 2; ++i) {
            const f32x4 v = *(const f32x4*)(src + (size_t)(r0 + r + 32 * i) * C + c0 + c4);
            float* d = tile + (r + 32 * i) * 65 + c4;
            d[0] = v[0]; d[1] = v[1]; d[2] = v[2]; d[3] = v[3];
        }
    }
    __syncthreads();
    {
        const int cc = t >> 3, rr = (t & 7) * 8;
        float v[8];
#pragma unroll
        for (int e = 0; e < 8; ++e) v[e] = tile[(rr + e) * 65 + cc];
        u32x4 w; w.x = cvt_pk_bf16(v[0], v[1]); w.y = cvt_pk_bf16(v[2], v[3]); w.z = cvt_pk_bf16(v[4], v[5]); w.w = cvt_pk_bf16(v[6], v[7]);
        *(u32x4*)(dst + (size_t)rm(c0 + cc) * dld + r0 + rr) = w;
    }
    __syncthreads();
}
template <class RM>
__device__ __forceinline__ void tcvt_tile_f8(const float* __restrict__ src, int C, int r0, int c0, unsigned char* __restrict__ dst, int dld, RM rm, float scale) {
    float* tile = (float*)g_lds;
    const int t = threadIdx.x;
    {
        const int r = t >> 4, c4 = (t & 15) * 4;
#pragma unroll
        for (int i = 0; i < 2; ++i) {
            const f32x4 v = *(const f32x4*)(src + (size_t)(r0 + r + 32 * i) * C + c0 + c4);
            float* d = tile + (r + 32 * i) * 65 + c4;
            d[0] = v[0]; d[1] = v[1]; d[2] = v[2]; d[3] = v[3];
        }
    }
    __syncthreads();
    {
        const int cc = t >> 3, rr = (t & 7) * 8;
        float v[8];
#pragma unroll
        for (int e = 0; e < 8; ++e) v[e] = tile[(rr + e) * 65 + cc] * scale;
        u32x2 w; w.x = pk_fp8x4(v[0], v[1], v[2], v[3]); w.y = pk_fp8x4(v[4], v[5], v[6], v[7]);
        *(u32x2*)(dst + (size_t)rm(c0 + cc) * dld + r0 + rr) = w;
    }
    __syncthreads();
}
template <class RM>
__device__ __forceinline__ void tcvt_wide_f8(const float* __restrict__ src, int C, int r0, int c0, unsigned char* __restrict__ dst, int dld, RM rm, float scale) {
    float* tile = (float*)g_lds;
    const int t = threadIdx.x;
    {
        const int r = t >> 6, c4 = (t & 63) * 4;
        f32x4 v[8];
#pragma unroll
        for (int i = 0; i < 8; ++i) v[i] = *(const f32x4*)(src + (size_t)(r0 + r + 8 * i) * C + c0 + c4);
#pragma unroll
        for (int i = 0; i < 8; ++i) *(f32x4*)(tile + (r + 8 * i) * 260 + c4) = v[i];
    }
    __syncthreads();
    {
#pragma unroll
        for (int q = 0; q < 4; ++q) {
            const int cc = q * 64 + (t >> 3), rr = (t & 7) * 8;
            float v[8];
#pragma unroll
            for (int e = 0; e < 8; ++e) v[e] = tile[(rr + e) * 260 + cc] * scale;
            u32x2 w; w.x = pk_fp8x4(v[0], v[1], v[2], v[3]); w.y = pk_fp8x4(v[4], v[5], v[6], v[7]);
            *(u32x2*)(dst + (size_t)rm(c0 + cc) * dld + r0 + rr) = w;
        }
    }
    __syncthreads();
}
struct RmId { __device__ __forceinline__ int operator()(int n) const { return n; } };
struct RmGU { int add; __device__ __forceinline__ int operator()(int n) const { return (n >> 7) * 256 + add + (n & 127); } };

__device__ __forceinline__ void phase_a(const Params& p, int bid, int nb) {
    const int tid = threadIdx.x;
    float* lds = (float*)g_lds;
#ifndef REP_A1
#define REP_A1 1
#endif
#ifndef REP_A2
#define REP_A2 1
#endif
#ifndef REP_A3
#define REP_A3 1
#endif
#pragma unroll 1
    for (int ra1_ = 0; ra1_ < REP_A1; ++ra1_)
    for (int u = bid; u < 256; u += nb) {
#pragma unroll 6
        for (int it = 0; it < 17; ++it) {
            const int i4 = tid + NTHREADS * it;
            if (i4 < 33 * 256) { const int r = i4 >> 8, k4 = (i4 & 255) * 4;
                const f32x4 v = r < 32 ? *(const f32x4*)(p.c + r * 1024 + k4) : *(const f32x4*)(p.c_ctx + k4);
                *(f32x4*)(lds + i4 * 4) = (f32x4){siluf_(v[0]), siluf_(v[1]), siluf_(v[2]), siluf_(v[3])}; }
        }
        __syncthreads();
        float acc[33];
#pragma unroll
        for (int r = 0; r < 33; ++r) acc[r] = 0.f;
        const int cl = tid % 24, ks = tid / 24;
        if (ks < 16) {
            const float* wp = p.w_mod + (size_t)(ks * 64) * 6144 + u * 24 + cl;
#pragma unroll 1
            for (int k0 = 0; k0 < 64; k0 += 16) {
                float wv[16];
#pragma unroll
                for (int j = 0; j < 16; ++j) wv[j] = wp[(size_t)(k0 + j) * 6144];
#pragma unroll
                for (int j = 0; j < 16; ++j) {
                    const float* sk = lds + ks * 64 + k0 + j;
#pragma unroll
                    for (int r = 0; r < 33; ++r) acc[r] += sk[r * 1024] * wv[j];
                }
            }
        }
        __syncthreads();
        if (ks < 16) {
#pragma unroll
            for (int r = 0; r < 33; ++r) lds[(ks * 33 + r) * 24 + cl] = acc[r];
        }
        __syncthreads();
        for (int o = tid; o < 33 * 24; o += NTHREADS) {
            float s = 0.f;
#pragma unroll
            for (int k = 0; k < 16; ++k) s += lds[k * 33 * 24 + o];
            const int r = o / 24, col = u * 24 + o % 24;
            ((float*)(p.ws + WS_MOD))[r * 6144 + col] = s + p.b_mod[col];
        }
        __syncthreads();
    }
#pragma unroll 1
    for (int ra2_ = 0; ra2_ < REP_A2; ++ra2_)
    for (int u = bid; u < 256; u += nb) {
        float* feats = lds;
        float* h1 = lds + 512;
        float* h2 = lds + 1024;
        float* w1s = lds + 2048;
        float* w2s = lds + 2048 + 2112;
        for (int i = tid; i < 2112; i += NTHREADS) w1s[i] = p.fw1[i];
#pragma unroll
        for (int i = 0; i < 8; ++i) w2s[tid + 512 * i] = p.fw2[tid + 512 * i];
        if (tid < 8 * 33) {
            const int pp = tid / 33, j = tid % 33; const int pos = u * 8 + pp;
            const float posf = (float)pos; const float tt = posf / 2047.0f; const float w = (6.283185307179586f / 2048.0f) * posf;
            float v;
            if (j == 0) v = tt;
            else { const int bi = (j - 1) & 15; const float band = 1e-4f + (15.0f - 1e-4f) * ((float)bi / 15.0f); const float a = band * w; v = (j <= 16) ? cosf(a) : -sinf(a); }
            feats[pp * 33 + j] = v;
        }
        __syncthreads();
        { const int pp = tid >> 6, j = tid & 63; float a = p.fb1[j];
#pragma unroll 11
          for (int k = 0; k < 33; ++k) a += feats[pp * 33 + k] * w1s[k * 64 + j];
          h1[pp * 64 + j] = sinf(p.freq[j] * a); }
        __syncthreads();
        { const int pp = tid >> 6, j = tid & 63; float a = p.fb2[j];
#pragma unroll 16
          for (int k = 0; k < 64; ++k) a += h1[pp * 64 + k] * w2s[k * 64 + j];
          h2[pp * 64 + j] = sinf(p.freq[j] * a); }
        __syncthreads();
        {
            float acc[4][8];
#pragma unroll
            for (int i = 0; i < 4; ++i)
#pragma unroll
                for (int pp = 0; pp < 8; ++pp) acc[i][pp] = 0.f;
#pragma unroll 1
            for (int k0 = 0; k0 < 64; k0 += 8) {
                float wv[8][4];
#pragma unroll
                for (int j = 0; j < 8; ++j)
#pragma unroll
                    for (int i = 0; i < 4; ++i) wv[j][i] = p.fw3[(k0 + j) * 2048 + tid + 512 * i];
#pragma unroll
                for (int j = 0; j < 8; ++j)
#pragma unroll
                    for (int pp = 0; pp < 8; ++pp) { const float hv = h2[pp * 64 + k0 + j];
#pragma unroll
                        for (int i = 0; i < 4; ++i) acc[i][pp] += hv * wv[j][i]; }
            }
            const int ch = tid;
            const float mind = -4.605170185988091f / 1.5f, maxd = -4.605170185988091f / 0.3f;
            const float delta = fabsf(mind + (maxd - mind) * ((float)ch / 511.0f));
            float* filt = (float*)(p.ws + WS_FILT);
            float* hn = (float*)(p.ws + WS_HNORM) + (size_t)u * 1024;
#pragma unroll
            for (int o = 0; o < 2; ++o) {
                float s = 0.f;
                float* R = filt + ((size_t)o * 512 + ch) * 4096;
                float fv[8], bv[8];
#pragma unroll
                for (int pp = 0; pp < 8; ++pp) {
                    const int pos = u * 8 + pp; const float tt = (float)pos / 2047.0f; const float win = __expf(-tt * delta);
                    fv[pp] = acc[2 * o][pp] * win; bv[pp] = acc[2 * o + 1][pp] * win;
                    s += fabsf(fv[pp]) + fabsf(bv[pp]);
                }
                if (u == 0) { fv[0] += bv[0]; }
                *(f32x4*)(R + 2040 - 8 * u) = (f32x4){fv[7], fv[6], fv[5], fv[4]};
                *(f32x4*)(R + 2044 - 8 * u) = (f32x4){fv[3], fv[2], fv[1], fv[0]};
                if (u == 0) { R[2048] = bv[1]; R[2049] = bv[2]; R[2050] = bv[3]; R[2051] = bv[4]; R[2052] = bv[5]; R[2053] = bv[6]; R[2054] = bv[7]; R[4095] = 0.f; }
                else {
#pragma unroll
                    for (int pp = 0; pp < 8; ++pp) R[2047 + 8 * u + pp] = bv[pp];
                }
                hn[o * 512 + ch] = s;
            }
        }
        __syncthreads();
    }
#pragma unroll 1
    for (int ra3_ = 0; ra3_ < REP_A3; ++ra3_)
    for (int tIdx = bid; tIdx < 256 + 64 + 16; tIdx += nb) {
        if (tIdx < 256) tcvt_wide_f8(p.w_in, 4096, (tIdx >> 4) * 64, (tIdx & 15) * 256, p.ws + WS_WIN, 1024, RmId(), WSCALE);
        else if (tIdx < 320) { const int q = tIdx - 256; tcvt_wide_f8(p.w_out, 1024, (q >> 2) * 64, (q & 3) * 256, p.ws + WS_WOUT, 1024, RmId(), WSCALE); }
        else { const int q = tIdx - 320;
#pragma unroll
            for (int c = 0; c < 4; ++c) tcvt_tile(p.w_router, 256, q * 64, c * 64, (bf16_t*)(p.ws + WS_WR), 1024, RmId()); }
    }
}

template <int MODE, class BF>
__device__ __forceinline__ void norm_rows(const float* __restrict__ src, int rows, const float* __restrict__ g, const float* __restrict__ mod, int sh, int sc,
                                          bf16_t* __restrict__ dst, unsigned char* __restrict__ dst8, BF batch_of, int bid, int nb) {
    const int wid = threadIdx.x >> 6, lane = threadIdx.x & 63;
    for (int tile = bid; tile * 256 < rows; tile += nb) {
        const float* mrow = mod + (size_t)batch_of(tile * 256) * 6144;
        f32x4 gs[4], shv[4];
#pragma unroll
        for (int i = 0; i < 4; ++i) {
            const int col = i * 256 + lane * 4;
            const f32x4 gv = *(const f32x4*)(g + col), scv = *(const f32x4*)(mrow + sc * 1024 + col);
            shv[i] = *(const f32x4*)(mrow + sh * 1024 + col);
#pragma unroll
            for (int j = 0; j < 4; ++j) gs[i][j] = gv[j] * (1.0f + scv[j]);
        }
#pragma unroll 4
        for (int k = 0; k < 32; ++k) {
            const int r = tile * 256 + wid + 8 * k;
            const float* xr = src + (size_t)r * 1024;
            f32x4 v[4]; float ss = 0.f;
#pragma unroll
            for (int i = 0; i < 4; ++i) {
                if (MODE == 2) {
                    const u32x2 w = *(const u32x2*)((const unsigned char*)xr + (i * 256 + lane * 4) * 2);
                    v[i] = (f32x4){__uint_as_float(w.x << 16), __uint_as_float(w.x & 0xffff0000u), __uint_as_float(w.y << 16), __uint_as_float(w.y & 0xffff0000u)};
                } else v[i] = *(const f32x4*)(xr + i * 256 + lane * 4);
                ss += v[i][0] * v[i][0] + v[i][1] * v[i][1] + v[i][2] * v[i][2] + v[i][3] * v[i][3];
            }
            ss = wave_sum(ss);
            const float rs = rsqrtf(ss * (1.0f / 1024.0f) + EPS);
#pragma unroll
            for (int i = 0; i < 4; ++i) {
                const int col = i * 256 + lane * 4;
                float o[4];
#pragma unroll
                for (int j = 0; j < 4; ++j) o[j] = (v[i][j] * rs) * gs[i][j] + shv[i][j];
                if (MODE != 1) { u32x2 w; w.x = cvt_pk_bf16(o[0], o[1]); w.y = cvt_pk_bf16(o[2], o[3]); *(u32x2*)(dst + (size_t)r * 1024 + col) = w; }
                if (MODE != 0) *(unsigned*)(dst8 + (size_t)r * 1024 + col) = pk_fp8x4(o[0], o[1], o[2], o[3]);
            }
        }
    }
}
struct BatchLat { __device__ __forceinline__ int operator()(int r) const { return r >> 11; } };
struct BatchCtx { __device__ __forceinline__ int operator()(int) const { return 32; } };

constexpr int LDS_CONVW = 131072 + 8192;
struct EpiHy {
    const Params* p; int pm, pn;
    __device__ __forceinline__ void operator()(f32x4 (&acc)[2][2][4][2], int wr, int wc, int fr, int fq) const {
        int tz = threadIdx.x; asm volatile("" : "+v"(tz));
        const int lane = tz & 63, fq_ = lane >> 4, fr_ = lane & 15;
        const int up = ((lane - 16) & 63) * 4, dn = ((lane + 16) & 63) * 4;
        const int b = pm >> 3, t0 = (pm & 7) * 256;
        bf16_t* U = (bf16_t*)(p->ws + WS_U);
        const float* cw = (const float*)(g_lds + LDS_CONVW) + ((pn >> 2) & 1) * 1024;
#pragma unroll
        for (int ai = 0; ai < 2; ++ai)
#pragma unroll
            for (int m = 0; m < 4; ++m) {
                const int cl = ai * 128 + wr * 64 + m * 16 + fr_;
                const float w0 = cw[cl], w1 = cw[256 + cl], w2 = cw[512 + cl], cb = cw[768 + cl];
                float x0[8], x1[8];
#pragma unroll
                for (int n = 0; n < 2; ++n)
#pragma unroll
                    for (int j = 0; j < 4; ++j) { x0[n * 4 + j] = acc[ai][0][m][n][j]; x1[n * 4 + j] = acc[ai][1][m][n][j]; }
                const float l0r = __int_as_float(__builtin_amdgcn_ds_bpermute(up, __float_as_int(x0[7])));
                const float l1 = __int_as_float(__builtin_amdgcn_ds_bpermute(up, __float_as_int(fq_ == 3 ? x0[7] : x1[7])));
                const float r0 = __int_as_float(__builtin_amdgcn_ds_bpermute(dn, __float_as_int(fq_ == 0 ? x1[0] : x0[0])));
                const float r1r = __int_as_float(__builtin_amdgcn_ds_bpermute(dn, __float_as_int(x1[0])));
                const float l0 = fq_ > 0 ? l0r : 0.f, r1 = fq_ < 3 ? r1r : 0.f;
                bf16_t* dst = U + ((size_t)(pn * 256 + cl) * 32 + b) * 2048 + t0 + 64 * wc + 8 * fq_;
                {
                    float o[8];
#pragma unroll
                    for (int e = 0; e < 8; ++e) o[e] = w0 * (e == 0 ? l0 : x0[e - 1]) + w1 * x0[e] + w2 * (e == 7 ? r0 : x0[e + 1]) + cb;
                    u32x4 w; w.x = cvt_pk_bf16(o[0], o[1]); w.y = cvt_pk_bf16(o[2], o[3]); w.z = cvt_pk_bf16(o[4], o[5]); w.w = cvt_pk_bf16(o[6], o[7]);
                    *(u32x4*)dst = w;
                }
                {
                    float o[8];
#pragma unroll
                    for (int e = 0; e < 8; ++e) o[e] = w0 * (e == 0 ? l1 : x1[e - 1]) + w1 * x1[e] + w2 * (e == 7 ? r1 : x1[e + 1]) + cb;
                    u32x4 w; w.x = cvt_pk_bf16(o[0], o[1]); w.y = cvt_pk_bf16(o[2], o[3]); w.z = cvt_pk_bf16(o[4], o[5]); w.w = cvt_pk_bf16(o[6], o[7]);
                    *(u32x4*)(dst + 32) = w;
                }
            }
    }
};
struct EpiP1 {
    const Params* p; int pm, pn, isctx;
    __device__ __forceinline__ void operator()(f32x4 (&acc)[2][2][4][2], int wr, int wc, int fr, int fq) const {
        unsigned char* ws = p->ws;
        const int tid = threadIdx.x;
        if (pn < 6) {
            float* stg = (float*)g_lds;
            const int b = pm >> 3, t0 = (pm & 7) * 256;
            bf16_t* U = (bf16_t*)(ws + WS_U);
#ifndef REP_C_HYEPI
#define REP_C_HYEPI 1
#endif
#pragma unroll 1
            for (int rep_ = 0; rep_ < REP_C_HYEPI; ++rep_)
#pragma unroll
            for (int ai = 0; ai < 2; ++ai) {
#pragma unroll
                for (int bj = 0; bj < 2; ++bj)
#pragma unroll
                    for (int m = 0; m < 4; ++m)
#pragma unroll
                        for (int n = 0; n < 2; ++n)
#pragma unroll
                            for (int j = 0; j < 4; ++j) stg[(bj * 128 + wc * 32 + n * 16 + 4 * fq + j) * 132 + wr * 64 + m * 16 + fr] = acc[ai][bj][m][n][j];
                __syncthreads();
                {
                    const int col = tid >> 1, hr = tid & 1, c3 = pn * 256 + col;
                    const float w0 = p->hy_conv_w[c3], w1 = p->hy_conv_w[1536 + c3], w2 = p->hy_conv_w[3072 + c3], cb = p->hy_conv_b[c3];
                    const float* s = stg + col * 132 + hr * 64;
                    bf16_t* dst = U + ((size_t)c3 * 32 + b) * 2048 + t0 + ai * 128 + hr * 64;
                    float prev = 0.f;
#pragma unroll
                    for (int ch = 0; ch < 8; ++ch) {
                        float v[9];
#pragma unroll
                        for (int e = 0; e < 8; ++e) v[e] = s[ch * 8 + e];
                        v[8] = (ch < 7) ? s[ch * 8 + 8] : 0.f;
                        float o[8];
#pragma unroll
                        for (int e = 0; e < 8; ++e) { const float l = (e == 0) ? prev : v[e - 1]; o[e] = w0 * l + w1 * v[e] + w2 * v[e + 1] + cb; }
                        prev = v[7];
                        u32x4 w; w.x = cvt_pk_bf16(o[0], o[1]); w.y = cvt_pk_bf16(o[2], o[3]); w.z = cvt_pk_bf16(o[4], o[5]); w.w = cvt_pk_bf16(o[6], o[7]);
                        *(u32x4*)(dst + ch * 8) = w;
                    }
                }
                __syncthreads();
            }
            return;
        }
        const int grp = (pn - 6) >> 1;
        const int half = (pn - 6) & 1;
        unsigned char* tile = g_lds;
#pragma unroll
        for (int bj = 0; bj < 2; ++bj)
#pragma unroll
            for (int n = 0; n < 2; ++n) {
                float lbv[4] = {0.f, 0.f, 0.f, 0.f};
                if (grp == 1 || grp == 2) {
                    const float* lg = p->lb_logits + (grp - 1) * 1024 + (half * 2 + bj) * 128 + wc * 32 + n * 16 + 4 * fq;
#pragma unroll
                    for (int j = 0; j < 4; ++j) lbv[j] = __builtin_amdgcn_rcpf(1.0f + __expf(lg[512 + j] - lg[j]));
                }
#pragma unroll
                for (int ai = 0; ai < 2; ++ai)
#pragma unroll
                    for (int m = 0; m < 4; ++m) {
                        const int rl = ai * 128 + wr * 64 + m * 16 + fr;
                        const f32x4 v = acc[ai][bj][m][n];
                        u32x2 w;
                        if (grp == 0) {
                            const float sc = 0.08838834764831845f;
                            w.x = cvt_pk_bf16(siluf_(v[0]) * sc, siluf_(v[1]) * sc); w.y = cvt_pk_bf16(siluf_(v[2]) * sc, siluf_(v[3]) * sc);
                        } else if (grp == 1 || grp == 2) {
                            float lf[4];
#pragma unroll
                            for (int j = 0; j < 4; ++j) { const float lb = lbv[j]; lf[j] = __logf(lb + (1.0f - lb) * sigmoidf_(v[j])); }
                            f16x2 h0, h1; h0.x = (_Float16)lf[0]; h0.y = (_Float16)lf[1]; h1.x = (_Float16)lf[2]; h1.y = (_Float16)lf[3];
                            w.x = __builtin_bit_cast(unsigned, h0); w.y = __builtin_bit_cast(unsigned, h1);
                        } else if (grp == 3) {
                            w.x = cvt_pk_bf16(v[0], v[1]); w.y = cvt_pk_bf16(v[2], v[3]);
                        } else {
                            w.x = cvt_pk_bf16(siluf_(v[0]), siluf_(v[1])); w.y = cvt_pk_bf16(siluf_(v[2]), siluf_(v[3]));
                        }
                        *(u32x2*)(tile + rl * 528 + (bj * 128 + wc * 32 + n * 16 + 4 * fq) * 2) = w;
                    }
            }
        __syncthreads();
        {
            const int LL = isctx ? CTX : SEQ;
            unsigned char* base;
            if (grp == 0) base = ws + WS_Q;
            else if (grp == 1 || grp == 2) base = (isctx ? ws + WS_LFC : ws + WS_LF) + (size_t)(grp - 1) * 32 * 4 * LL * 256;
            else if (grp == 3) base = isctx ? ws + WS_VC : ws + WS_V;
            else base = ws + WS_G;
            int tz = threadIdx.x; asm volatile("" : "+v"(tz));
#pragma unroll
            for (int i = 0; i < 16; ++i) {
                const int idx = tz + 512 * i, rl = idx >> 5, c16 = idx & 31;
                int b, t;
                if (isctx) { b = pm; t = rl; } else { b = pm >> 3; t = (pm & 7) * 256 + rl; }
                unsigned char* dst;
                if (grp == 4) dst = base + ((size_t)b * SEQ + t) * 1024 + half * 512 + c16 * 16;
                else dst = base + ((((size_t)b * 4 + half * 2 + (c16 >> 4)) * LL + t) * 128) * 2 + (c16 & 15) * 16;
                *(u32x4*)dst = *(const u32x4*)(tile + rl * 528 + c16 * 16);
            }
        }
        __syncthreads();
    }
};

constexpr int LDS_LB = 131072 + 16384;
struct EpiP1D {
    const Params* p; int pm, pn, isctx;
    __device__ __forceinline__ void operator()(f32x4 (&acc)[2][2][4][2], int wr, int wc, int fr, int fq) const {
        unsigned char* ws = p->ws;
        const int grp = (pn - 6) >> 1, half = (pn - 6) & 1;
        const int LL = isctx ? CTX : SEQ;
        unsigned char* base;
        if (grp == 0) base = ws + WS_Q;
        else if (grp == 1 || grp == 2) base = (isctx ? ws + WS_LFC : ws + WS_LF) + (size_t)(grp - 1) * 32 * 4 * LL * 256;
        else if (grp == 3) base = isctx ? ws + WS_VC : ws + WS_V;
        else base = ws + WS_G;
        int tz = threadIdx.x; asm volatile("" : "+v"(tz));
        const int fr_ = tz & 15, fq_ = (tz >> 4) & 3;
        const int b = isctx ? pm : pm >> 3, t0 = isctx ? 0 : (pm & 7) * 256;
#pragma unroll
        for (int bj = 0; bj < 2; ++bj) {
            const int c8 = wc * 32 + 8 * fq_;
            float lbv[8];
            if (grp == 1 || grp == 2) {
                const float* lb = (const float*)(g_lds + LDS_LB) + (grp - 1) * 512 + (half * 2 + bj) * 128 + c8;
                const f32x4 l0 = *(const f32x4*)lb, l1 = *(const f32x4*)(lb + 4);
                lbv[0] = l0[0]; lbv[1] = l0[1]; lbv[2] = l0[2]; lbv[3] = l0[3]; lbv[4] = l1[0]; lbv[5] = l1[1]; lbv[6] = l1[2]; lbv[7] = l1[3];
            }
            unsigned char* cb;
            if (grp == 4) cb = base + ((size_t)b * SEQ + t0) * 1024 + half * 512 + (bj * 128 + c8) * 2;
            else cb = base + (((size_t)b * 4 + half * 2 + bj) * LL + t0) * 256 + c8 * 2;
            const int rstride = grp == 4 ? 1024 : 256;
#pragma unroll
            for (int ai = 0; ai < 2; ++ai)
#pragma unroll
                for (int m = 0; m < 4; ++m) {
                    const int rl = ai * 128 + wr * 64 + m * 16 + fr_;
                    float v[8];
#pragma unroll
                    for (int n = 0; n < 2; ++n)
#pragma unroll
                        for (int j = 0; j < 4; ++j) v[n * 4 + j] = acc[ai][bj][m][n][j];
                    u32x4 w;
                    if (grp == 0) {
                        const float sc = 0.08838834764831845f;
#pragma unroll
                        for (int j = 0; j < 8; ++j) v[j] = siluf_(v[j]) * sc;
                        w.x = cvt_pk_bf16(v[0], v[1]); w.y = cvt_pk_bf16(v[2], v[3]); w.z = cvt_pk_bf16(v[4], v[5]); w.w = cvt_pk_bf16(v[6], v[7]);
                    } else if (grp == 1 || grp == 2) {
#pragma unroll
                        for (int j = 0; j < 8; ++j) v[j] = __logf(lbv[j] + (1.0f - lbv[j]) * sigmoidf_(v[j]));
                        f16x2 h0, h1, h2, h3; h0.x = (_Float16)v[0]; h0.y = (_Float16)v[1]; h1.x = (_Float16)v[2]; h1.y = (_Float16)v[3];
                        h2.x = (_Float16)v[4]; h2.y = (_Float16)v[5]; h3.x = (_Float16)v[6]; h3.y = (_Float16)v[7];
                        w.x = __builtin_bit_cast(unsigned, h0); w.y = __builtin_bit_cast(unsigned, h1); w.z = __builtin_bit_cast(unsigned, h2); w.w = __builtin_bit_cast(unsigned, h3);
                    } else if (grp == 3) {
                        w.x = cvt_pk_bf16(v[0], v[1]); w.y = cvt_pk_bf16(v[2], v[3]); w.z = cvt_pk_bf16(v[4], v[5]); w.w = cvt_pk_bf16(v[6], v[7]);
                    } else {
#pragma unroll
                        for (int j = 0; j < 8; ++j) v[j] = siluf_(v[j]);
                        w.x = cvt_pk_bf16(v[0], v[1]); w.y = cvt_pk_bf16(v[2], v[3]); w.z = cvt_pk_bf16(v[4], v[5]); w.w = cvt_pk_bf16(v[6], v[7]);
                    }
                    *(u32x4*)(cb + (size_t)rl * rstride) = w;
                }
        }
    }
};
__device__ __forceinline__ void load_convw(const Params& p, int pn, int& cached) {
    if (pn == cached) return;
    cached = pn;
    __syncthreads();
    if (threadIdx.x < 256) {
        const int c3 = pn * 256 + threadIdx.x; float* cw = (float*)(g_lds + LDS_CONVW) + ((pn >> 2) & 1) * 1024;
        cw[threadIdx.x] = p.hy_conv_w[c3]; cw[256 + threadIdx.x] = p.hy_conv_w[1536 + c3]; cw[512 + threadIdx.x] = p.hy_conv_w[3072 + c3]; cw[768 + threadIdx.x] = p.hy_conv_b[c3];
    }
}
__device__ __forceinline__ void phase_c(const Params& p, int bid, int nb) {
    int cw_pn = -1;
    unsigned tokv;
    { int R0, C0; g_thread_rc(R0, C0); tokv = (unsigned)(64 * (R0 >> 5) + perm32(R0 & 31)) * 1024u + (unsigned)C0 * 2u; }
    const __amdgpu_buffer_rsrc_t ra = G_RSRC(p.ws + WS_HX, (size_t)(T + TC) * 1024);
    const __amdgpu_buffer_rsrc_t rb = G_RSRC(p.ws + WS_WIN, (size_t)4096 * 1024);
    unsigned av[4]; av[0] = dense_voff(512); av[1] = av[2] = av[3] = 0u;
    const unsigned bv = dense_voff_perm(512);
    __syncthreads();
    for (int i = threadIdx.x; i < 1024; i += NTHREADS) {
        const float* lg = p.lb_logits + (i >> 9) * 1024 + (i & 511);
        ((float*)(g_lds + LDS_LB))[i] = __builtin_amdgcn_rcpf(1.0f + __expf(lg[512] - lg[0]));
    }
    __syncthreads();
    if ((nb & 31) == 0) {
        const int x = bid & 7, r = bid >> 3, R = nb >> 3, G = R >> 2;
        const int xq = x & 3, xh = x >> 2, q4 = r & 3, s = r >> 2;
        const int nlat = (128 - s + G - 1) / G;
        const int ncx = 16 * (xq < 2 ? 2 : 1), nctx = r < ncx ? (ncx - r + R - 1) / R : 0;
        load_convw(p, xq, cw_pn);
        if (xq < 2) load_convw(p, xq + 4, cw_pn);
        __syncthreads();
        for (int j = 0; j < nlat + nctx; ++j) {
            EpiP1D e; e.p = &p;
            int arow;
            if (j < nlat) { e.pm = xh * 128 + s + G * j; e.pn = xq + 4 * ((q4 + j) & 3); e.isctx = 0; arow = e.pm * 256; }
            else { const int u = r + R * (j - nlat); e.pm = xh * 16 + (u & 15); e.pn = xq + 8 + 4 * (u >> 4); e.isctx = 1; arow = T + e.pm * 256; }
            if (e.pn < 6) { EpiHy eh; eh.p = &p; eh.pm = e.pm; eh.pn = e.pn;
                gemm_unit_x<false, true, E8_1, E8_2M5, 32, 128>(rb, av, (unsigned)(e.pn * 256) * 1024u, 1024u, ra, tokv, (unsigned)arow * 1024u, 1024u, 8, eh); }
            else
            gemm_unit<false, true, E8_2M5, E8_1>(ra, av, (unsigned)arow * 1024u, 1024u, rb, bv, (unsigned)(e.pn * 256) * 1024u, 1024u, 8, e);
        }
    } else
    for (int u = bid; u < 4096 + 192; u += nb) {
        EpiP1D e; e.p = &p;
        int arow;
        if (u < 4096) { e.pm = u >> 4; e.pn = u & 15; e.isctx = 0; arow = e.pm * 256; }
        else { const int q = u - 4096; e.pm = q / 6; e.pn = 8 + q % 6; e.isctx = 1; arow = T + e.pm * 256; }
        if (e.pn < 6) { load_convw(p, e.pn, cw_pn); EpiHy eh; eh.p = &p; eh.pm = e.pm; eh.pn = e.pn;
            gemm_unit_x<false, true, E8_1, E8_2M5, 32, 128>(rb, av, (unsigned)(e.pn * 256) * 1024u, 1024u, ra, tokv, (unsigned)arow * 1024u, 1024u, 8, eh); }
        else
        gemm_unit<false, true, E8_2M5, E8_1>(ra, av, (unsigned)arow * 1024u, 1024u, rb, bv, (unsigned)(e.pn * 256) * 1024u, 1024u, 8, e);
    }
}

__device__ __forceinline__ void phase_hgrn_naive(const Params& p, int bid, int nb, size_t o_off) {
    const int tid = threadIdx.x, v = tid & 127, dq = tid >> 7;
    float* lds = (float*)g_lds;
    float* fs = lds; float* ks = lds + 128; float* vs = lds + 256; float* qs = lds + 384; float* red = lds + 512;
    const unsigned char* ws = p.ws;
    for (int u = bid; u < 256; u += nb) {
        const int dir = u & 1, h = (u >> 1) & 3, b = u >> 3;
        float S[32];
#pragma unroll
        for (int i = 0; i < 32; ++i) S[i] = 0.f;
        const _Float16* lfc = (const _Float16*)(ws + WS_LFC) + (((size_t)dir * 32 + b) * 4 + h) * CTX * 128;
        const bf16_t* vc = (const bf16_t*)(ws + WS_VC) + ((size_t)b * 4 + h) * CTX * 128;
        const _Float16* lfl = (const _Float16*)(ws + WS_LF) + (((size_t)dir * 32 + b) * 4 + h) * SEQ * 128;
        const bf16_t* vl = (const bf16_t*)(ws + WS_V) + ((size_t)b * 4 + h) * SEQ * 128;
        const bf16_t* ql = (const bf16_t*)(ws + WS_Q) + ((size_t)b * 4 + h) * SEQ * 128;
        bf16_t* O = (bf16_t*)(p.ws + o_off) + (size_t)dir * T * 512;
        const int NS = CTX + SEQ;
        float nxt = 0.f;
        { const int t = dir ? CTX - 1 : 0;
          if (dq == 0) nxt = (float)lfc[t * 128 + v]; else if (dq == 1) nxt = bf2f(vc[t * 128 + v]); }
        for (int s = 0; s < NS; ++s) {
            const bool lat = s >= CTX;
#if PROBE_HGRN == 6
            if (s == CTX) {
#pragma unroll
                for (int i = 0; i < 32; ++i) S[i] = 0.f;
            }
#endif
            const float cur = nxt;
            if (s + 1 < NS) {
                const int s1 = s + 1;
                if (s1 < CTX) { const int t = dir ? CTX - 1 - s1 : s1;
                    if (dq == 0) nxt = (float)lfc[t * 128 + v]; else if (dq == 1) nxt = bf2f(vc[t * 128 + v]); }
                else { const int i = s1 - CTX; const int t = dir ? SEQ - 1 - i : i;
                    if (dq == 0) nxt = (float)lfl[(size_t)t * 128 + v]; else if (dq == 1) nxt = bf2f(vl[(size_t)t * 128 + v]); else if (dq == 2) nxt = bf2f(ql[(size_t)t * 128 + v]); }
            }
            if (dq == 0) { const float f = __expf(cur); fs[v] = f; ks[v] = 1.0f - f; } else if (dq == 1) vs[v] = cur; else if (dq == 2) qs[v] = cur;
            __syncthreads();
            const float vv = vs[v];
            float po = 0.f;
#pragma unroll
            for (int dd = 0; dd < 32; ++dd) { const int d = dq * 32 + dd; S[dd] = fs[d] * S[dd] + ks[d] * vv; po += S[dd] * qs[d]; }
            if (lat) {
                red[dq * 128 + v] = po;
                __syncthreads();
                if (dq == 0) { const int i = s - CTX; const int t = dir ? SEQ - 1 - i : i;
                    O[((size_t)b * SEQ + t) * 512 + h * 128 + v] = (bf16_t)(cvt_pk_bf16(red[v] + red[128 + v] + red[256 + v] + red[384 + v], 0.f) & 0xffffu); }
            }
            __syncthreads();
        }
    }
}

__device__ __forceinline__ f32x16 zero_acc16() {
    float z = 0.f; asm volatile("" : "+v"(z));
    f32x16 a;
#pragma unroll
    for (int r = 0; r < 16; ++r) a[r] = z;
    return a;
}
constexpr int HG_RAWQ = 0, HG_ATT = 0, HG_RAWL = 16384, HG_RAWV = 32768, HG_QM = 49152, HG_KM = 66560, HG_KMT = 83968, HG_VT = 102400, HG_ST = 120832, HG_GSUM = 155648;
__device__ __forceinline__ void phase_hgrn_mfma(const Params& p, int bid, int nb, size_t o_off = WS_O) {
    const int tid = threadIdx.x, lane = tid & 63, w = tid >> 6, li = lane & 31, hh = lane >> 5;
    unsigned char* L = g_lds;
    float* gsum = (float*)(L + HG_GSUM);
    for (int u = bid; u < 256; u += nb) {
        const int dir = u & 1, h = (u >> 1) & 3, b = u >> 3;
        const unsigned char* lfc = p.ws + WS_LFC + ((((size_t)dir * 32 + b) * 4 + h) * CTX) * 256;
        const unsigned char* vc = p.ws + WS_VC + (((size_t)b * 4 + h) * CTX) * 256;
        const unsigned char* lfl = p.ws + WS_LF + ((((size_t)dir * 32 + b) * 4 + h) * SEQ) * 256;
        const unsigned char* vl = p.ws + WS_V + (((size_t)b * 4 + h) * SEQ) * 256;
        const unsigned char* ql = p.ws + WS_Q + (((size_t)b * 4 + h) * SEQ) * 256;
        bf16_t* O = (bf16_t*)(p.ws + o_off) + (size_t)dir * T * 512;
        f32x16 S[2];
#pragma unroll
        for (int j = 0; j < 2; ++j)
#pragma unroll
            for (int r = 0; r < 16; ++r) S[j][r] = 0.f;
        u32x4 pq[2], pl[2], pv[2];
        { const int lr = tid >> 3, lpart = tid & 7;
          const int t = dir ? CTX - 1 - lr : lr;
          pl[0] = *(const u32x4*)(lfc + t * 256 + lpart * 32); pl[1] = *(const u32x4*)(lfc + t * 256 + lpart * 32 + 16);
          pv[0] = *(const u32x4*)(vc + t * 256 + lpart * 32); pv[1] = *(const u32x4*)(vc + t * 256 + lpart * 32 + 16);
          pq[0] = (u32x4){0u, 0u, 0u, 0u}; pq[1] = pq[0]; }
#pragma unroll 1
        for (int n = 0; n < 36; ++n) {
            const bool lat = n >= 4;
            int tz = tid; asm volatile("" : "+v"(tz));
            const int ed = tz & 127, ecg = tz >> 7;
            const int lr = tz >> 3, lpart = tz & 7;
            *(u32x4*)(L + HG_RAWQ + lr * 256 + lpart * 32) = pq[0]; *(u32x4*)(L + HG_RAWQ + lr * 256 + lpart * 32 + 16) = pq[1];
            *(u32x4*)(L + HG_RAWL + lr * 256 + lpart * 32) = pl[0]; *(u32x4*)(L + HG_RAWL + lr * 256 + lpart * 32 + 16) = pl[1];
            *(u32x4*)(L + HG_RAWV + lr * 256 + lpart * 32) = pv[0]; *(u32x4*)(L + HG_RAWV + lr * 256 + lpart * 32 + 16) = pv[1];
            if (n + 1 < 36) {
                const int n1 = n + 1;
                if (n1 < 4) { const int i = 64 * n1 + lr; const int t = dir ? CTX - 1 - i : i;
                    pl[0] = *(const u32x4*)(lfc + t * 256 + lpart * 32); pl[1] = *(const u32x4*)(lfc + t * 256 + lpart * 32 + 16);
                    pv[0] = *(const u32x4*)(vc + t * 256 + lpart * 32); pv[1] = *(const u32x4*)(vc + t * 256 + lpart * 32 + 16); }
                else { const int i = 64 * (n1 - 4) + lr; const size_t t = dir ? SEQ - 1 - i : i;
                    pl[0] = *(const u32x4*)(lfl + t * 256 + lpart * 32); pl[1] = *(const u32x4*)(lfl + t * 256 + lpart * 32 + 16);
                    pv[0] = *(const u32x4*)(vl + t * 256 + lpart * 32); pv[1] = *(const u32x4*)(vl + t * 256 + lpart * 32 + 16);
                    pq[0] = *(const u32x4*)(ql + t * 256 + lpart * 32); pq[1] = *(const u32x4*)(ql + t * 256 + lpart * 32 + 16); }
            }
            __syncthreads();
            float bl[16];
            { float run = 0.f;
#pragma unroll
              for (int i = 0; i < 16; ++i) { run += (float)*(const _Float16*)(L + HG_RAWL + (16 * ecg + i) * 256 + 2 * ed); bl[i] = run; }
              gsum[ecg * 128 + ed] = run; }
            __syncthreads();
            {
                const float g0 = gsum[ed], g1 = gsum[128 + ed], g2 = gsum[256 + ed];
                const float off = (ecg > 0 ? g0 : 0.f) + (ecg > 1 ? g1 : 0.f) + (ecg > 2 ? g2 : 0.f);
                const float bmid = g0 + g1;
                unsigned kp[8], vp[8];
#pragma unroll
                for (int i = 0; i < 16; i += 2) {
                    float km2[2];
#pragma unroll
                    for (int e = 0; e < 2; ++e) {
                        const int c = 16 * ecg + i + e;
                        const float bb = bl[i + e] + off;
                        const float f = __expf((i + e) ? bl[i + e] - bl[i + e - 1] : bl[0]);
                        const float e1 = __expf(bb - bmid), e2 = __expf(bmid - bb);
                        const float km = (1.0f - f) * e2;
                        km2[e] = km;
                        *(bf16_t*)(L + HG_KM + c * 272 + 2 * ed) = (bf16_t)(cvt_pk_bf16(km, 0.f) & 0xffffu);
                        if (lat) { const float qv = bf2f(*(const bf16_t*)(L + HG_RAWQ + c * 256 + 2 * ed));
                            *(bf16_t*)(L + HG_QM + c * 272 + 2 * ed) = (bf16_t)(cvt_pk_bf16(qv * e1, 0.f) & 0xffffu); }
                    }
                    kp[i >> 1] = cvt_pk_bf16(km2[0], km2[1]);
                    vp[i >> 1] = (unsigned)*(const bf16_t*)(L + HG_RAWV + (16 * ecg + i) * 256 + 2 * ed) | ((unsigned)*(const bf16_t*)(L + HG_RAWV + (16 * ecg + i + 1) * 256 + 2 * ed) << 16);
                }
                *(u32x4*)(L + HG_KMT + ed * 144 + 32 * ecg) = (u32x4){kp[0], kp[1], kp[2], kp[3]};
                *(u32x4*)(L + HG_KMT + ed * 144 + 32 * ecg + 16) = (u32x4){kp[4], kp[5], kp[6], kp[7]};
                *(u32x4*)(L + HG_VT + ed * 144 + 32 * ecg) = (u32x4){vp[0], vp[1], vp[2], vp[3]};
                *(u32x4*)(L + HG_VT + ed * 144 + 32 * ecg + 16) = (u32x4){vp[4], vp[5], vp[6], vp[7]};
            }
#if PROBE_HGRN == 6
            if (n == 4) {
#pragma unroll
                for (int j = 0; j < 2; ++j)
#pragma unroll
                    for (int r = 0; r < 16; ++r) S[j][r] = 0.f;
            }
#endif
            if (lat) {
                const int dt = w >> 1;
#pragma unroll
                for (int g = 0; g < 4; ++g) {
                    const int d0 = dt * 32 + 8 * g + 4 * hh;
                    const f32x4 a0 = *(const f32x4*)(gsum + d0), a1 = *(const f32x4*)(gsum + 128 + d0);
                    const float s0 = __expf(a0[0] + a1[0]), s1 = __expf(a0[1] + a1[1]), s2 = __expf(a0[2] + a1[2]), s3 = __expf(a0[3] + a1[3]);
#pragma unroll
                    for (int j = 0; j < 2; ++j) {
                        const int v = (2 * (w & 1) + j) * 32 + li;
                        u32x2 wv;
                        wv.x = cvt_pk_bf16(S[j][4 * g + 0] * s0, S[j][4 * g + 1] * s1);
                        wv.y = cvt_pk_bf16(S[j][4 * g + 2] * s2, S[j][4 * g + 3] * s3);
                        *(u32x2*)(L + HG_ST + v * 272 + 2 * d0) = wv;
                    }
                }
            }
            __syncthreads();
#if PROBE_HGRN == 7 && (PROBE_SUB & 1)
            if (lat) {
                const int c = tid >> 3, d = (tid & 7) * 16 + (n & 15);
                float bc = 0.f, bm = 0.f, lfc_ = 0.f;
#pragma unroll 1
                for (int cc = 0; cc < 64; ++cc) { const int i = 64 * (n - 4) + cc; const size_t t = dir ? SEQ - 1 - i : i;
                    const float l = (float)*(const _Float16*)(lfl + t * 256 + 2 * d);
                    if (cc <= c) bc += l; if (cc <= 31) bm += l; if (cc == c) lfc_ = l; }
                const int i = 64 * (n - 4) + c; const size_t t = dir ? SEQ - 1 - i : i;
                const float qv = bf2f(*(const bf16_t*)(ql + t * 256 + 2 * d));
                const float kmr = (1.0f - __expf(lfc_)) * __expf(bm - bc), qmr = qv * __expf(bc - bm);
                const float kml = bf2f(*(const bf16_t*)(L + HG_KM + c * 272 + 2 * d)), qml = bf2f(*(const bf16_t*)(L + HG_QM + c * 272 + 2 * d));
                const float kmt = bf2f(*(const bf16_t*)(L + HG_KMT + d * 144 + 2 * c));
                unsigned badA = 0;
                if (!(fabsf(kml - kmr) <= 0.02f * fabsf(kmr) + 1e-30f)) ++badA;
                if (!(fabsf(qml - qmr) <= 0.02f * fabsf(qmr) + 1e-30f)) ++badA;
                if (!(fabsf(kmt - kmr) <= 0.02f * fabsf(kmr) + 1e-30f)) ++badA;
                const unsigned short vraw = *(const bf16_t*)(vl + t * 256 + 2 * d), vlds = *(const bf16_t*)(L + HG_VT + d * 144 + 2 * c);
                unsigned badB = (vraw != vlds) ? 1u : 0u;
                if (badA) atomicAdd((unsigned*)(p.ws + WS_DIFF) + 0, badA);
                if (badB) atomicAdd((unsigned*)(p.ws + WS_DIFF) + 1, badB);
            }
#endif
#if PROBE_HGRN == 7 && (PROBE_SUB & 8)
            if (lat) {
                const int c = tid >> 3, d = (tid & 7) * 16 + (n & 15);
                float bc = 0.f, bm = 0.f, lfc_ = 0.f;
#pragma unroll 1
                for (int cc = 0; cc < 64; ++cc) { const int i = 64 * (n - 4) + cc; const size_t t = dir ? SEQ - 1 - i : i;
                    const float l = (float)*(const _Float16*)(lfl + t * 256 + 2 * d);
                    if (cc <= c) bc += l; if (cc <= 31) bm += l; if (cc == c) lfc_ = l; }
                const float kmr = (1.0f - __expf(lfc_)) * __expf(bm - bc);
                const float kml = bf2f(*(const bf16_t*)(L + HG_KM + c * 272 + 2 * d));
                if (!(fabsf(kml - kmr) <= 0.02f * fabsf(kmr) + 1e-30f)) atomicAdd((unsigned*)(p.ws + WS_DIFF) + 0, 1u);
            }
#endif
#if PROBE_HGRN == 7 && (PROBE_SUB & 32)
            if (lat) {
                const int c = tid >> 3, d = (tid & 7) * 16 + (n & 15);
                float bc = 0.f, bm = 0.f;
#pragma unroll 1
                for (int cc = 0; cc < 64; ++cc) { const int i = 64 * (n - 4) + cc; const size_t t = dir ? SEQ - 1 - i : i;
                    const float l = (float)*(const _Float16*)(lfl + t * 256 + 2 * d);
                    if (cc <= c) bc += l; if (cc <= 31) bm += l; }
                const int i = 64 * (n - 4) + c; const size_t t = dir ? SEQ - 1 - i : i;
                const float qmr = bf2f(*(const bf16_t*)(ql + t * 256 + 2 * d)) * __expf(bc - bm);
                const float qml = bf2f(*(const bf16_t*)(L + HG_QM + c * 272 + 2 * d));
                if (!(fabsf(qml - qmr) <= 0.02f * fabsf(qmr) + 1e-30f)) atomicAdd((unsigned*)(p.ws + WS_DIFF) + 2, 1u);
            }
#endif
#if PROBE_HGRN == 7 && (PROBE_SUB & 16)
            if (lat) {
                const int c = tid >> 3, d = (tid & 7) * 16 + (n & 15);
                const int i = 64 * (n - 4) + c; const size_t t = dir ? SEQ - 1 - i : i;
                const unsigned short vraw = *(const bf16_t*)(vl + t * 256 + 2 * d), vlds = *(const bf16_t*)(L + HG_VT + d * 144 + 2 * c);
                if (vraw != vlds) atomicAdd((unsigned*)(p.ws + WS_DIFF) + 1, 1u);
            }
#endif
            f32x16 accU0 = zero_acc16(), accU1 = zero_acc16();
            {
                const int dt = w >> 1, vt0 = 2 * (w & 1);
#pragma unroll
                for (int kk = 0; kk < 4; ++kk) {
                    const bf16x8 a = *(const bf16x8*)(L + HG_KMT + (dt * 32 + li) * 144 + 2 * (16 * kk + 8 * hh));
                    const bf16x8 b0 = *(const bf16x8*)(L + HG_VT + (vt0 * 32 + li) * 144 + 2 * (16 * kk + 8 * hh));
                    const bf16x8 b1 = *(const bf16x8*)(L + HG_VT + ((vt0 + 1) * 32 + li) * 144 + 2 * (16 * kk + 8 * hh));
                    accU0 = __builtin_amdgcn_mfma_f32_32x32x16_bf16(a, b0, accU0, 0, 0, 0);
                    accU1 = __builtin_amdgcn_mfma_f32_32x32x16_bf16(a, b1, accU1, 0, 0, 0);
                }
            }
            if (lat) {
                if (w < 4) {
                    const int st = w >> 1, ct = w & 1;
                    f32x16 acc = zero_acc16();
                    if (!(st == 1 && ct == 0)) {
#pragma unroll
                        for (int kk = 0; kk < 8; ++kk) {
                            const bf16x8 a = *(const bf16x8*)(L + HG_KM + (st * 32 + li) * 272 + 2 * (16 * kk + 8 * hh));
                            const bf16x8 bq = *(const bf16x8*)(L + HG_QM + (ct * 32 + li) * 272 + 2 * (16 * kk + 8 * hh));
                            acc = __builtin_amdgcn_mfma_f32_32x32x16_bf16(a, bq, acc, 0, 0, 0);
                        }
                    }
                    const int c = ct * 32 + li;
#pragma unroll
                    for (int g = 0; g < 4; ++g) {
                        const int s0 = st * 32 + 8 * g + 4 * hh;
                        u32x2 wv;
                        wv.x = cvt_pk_bf16(s0 + 0 <= c ? acc[4 * g + 0] : 0.f, s0 + 1 <= c ? acc[4 * g + 1] : 0.f);
                        wv.y = cvt_pk_bf16(s0 + 2 <= c ? acc[4 * g + 2] : 0.f, s0 + 3 <= c ? acc[4 * g + 3] : 0.f);
                        *(u32x2*)(L + HG_ATT + c * 144 + 2 * s0) = wv;
                    }
                }
                __syncthreads();
#if PROBE_HGRN == 7 && (PROBE_SUB & 2)
                {
                    const int c = tid >> 3, s = (tid & 7) * 8 + (n & 7);
                    float dot = 0.f;
#pragma unroll 1
                    for (int d = 0; d < 128; ++d) dot += bf2f(*(const bf16_t*)(L + HG_QM + c * 272 + 2 * d)) * bf2f(*(const bf16_t*)(L + HG_KM + s * 272 + 2 * d));
                    if (s > c) dot = 0.f;
                    const float al = bf2f(*(const bf16_t*)(L + HG_ATT + c * 144 + 2 * s));
                    if (!(fabsf(al - dot) <= 0.02f * fabsf(dot) + 1e-4f)) atomicAdd((unsigned*)(p.ws + WS_DIFF) + 2, 1u);
                }
#endif
                {
                    const int ct = w >> 2, vt = w & 3;
                    f32x16 acc = zero_acc16();
#pragma unroll
                    for (int kk = 0; kk < 4; ++kk) {
                        const bf16x8 a = *(const bf16x8*)(L + HG_ATT + (ct * 32 + li) * 144 + 2 * (16 * kk + 8 * hh));
                        const bf16x8 bv = *(const bf16x8*)(L + HG_VT + (vt * 32 + li) * 144 + 2 * (16 * kk + 8 * hh));
                        acc = __builtin_amdgcn_mfma_f32_32x32x16_bf16(a, bv, acc, 0, 0, 0);
                    }
#pragma unroll
                    for (int kk = 0; kk < 8; ++kk) {
                        const bf16x8 a = *(const bf16x8*)(L + HG_QM + (ct * 32 + li) * 272 + 2 * (16 * kk + 8 * hh));
                        const bf16x8 bs = *(const bf16x8*)(L + HG_ST + (vt * 32 + li) * 272 + 2 * (16 * kk + 8 * hh));
                        acc = __builtin_amdgcn_mfma_f32_32x32x16_bf16(a, bs, acc, 0, 0, 0);
                    }
                    const int v = vt * 32 + li;
#if PROBE_HGRN == 7 && (PROBE_SUB & 4)
                    {
                        const int r = 5, c = ct * 32 + (r & 3) + 8 * (r >> 2) + 4 * hh;
                        float ref = 0.f;
#pragma unroll 1
                        for (int s = 0; s < 64; ++s) ref += bf2f(*(const bf16_t*)(L + HG_ATT + c * 144 + 2 * s)) * bf2f(*(const bf16_t*)(L + HG_VT + v * 144 + 2 * s));
#pragma unroll 1
                        for (int d = 0; d < 128; ++d) ref += bf2f(*(const bf16_t*)(L + HG_QM + c * 272 + 2 * d)) * bf2f(*(const bf16_t*)(L + HG_ST + v * 272 + 2 * d));
                        if (!(fabsf(acc[r] - ref) <= 0.01f * fabsf(ref) + 1e-3f)) atomicAdd((unsigned*)(p.ws + WS_DIFF) + 3, 1u);
                    }
#endif
#pragma unroll
                    for (int r = 0; r < 16; ++r) {
                        const int c = ct * 32 + (r & 3) + 8 * (r >> 2) + 4 * hh;
                        const int i = 64 * (n - 4) + c; const size_t t = dir ? SEQ - 1 - i : i;
                        O[((size_t)b * SEQ + t) * 512 + h * 128 + v] = (bf16_t)(cvt_pk_bf16(acc[r], 0.f) & 0xffffu);
                    }
                }
            }
            {
                const int dt = w >> 1;
#pragma unroll
                for (int g = 0; g < 4; ++g) {
                    const int d0 = dt * 32 + 8 * g + 4 * hh;
                    const f32x4 a0 = *(const f32x4*)(gsum + d0), a1 = *(const f32x4*)(gsum + 128 + d0), a2 = *(const f32x4*)(gsum + 256 + d0), a3 = *(const f32x4*)(gsum + 384 + d0);
#pragma unroll
                    for (int k = 0; k < 4; ++k) {
                        const float hi = a2[k] + a3[k];
                        const float dec = __expf(a0[k] + a1[k] + hi), eu = __expf(hi);
                        S[0][4 * g + k] = dec * S[0][4 * g + k] + eu * accU0[4 * g + k];
                        S[1][4 * g + k] = dec * S[1][4 * g + k] + eu * accU1[4 * g + k];
                    }
                }
            }
            __syncthreads();
        }
    }
}

__device__ __forceinline__ void phase_hyena_naive(const Params& p, int bid, int nb) {
    const int tid = threadIdx.x;
    float* lds = (float*)g_lds;
    float* Rf = lds;
    float* zb = lds + 4096;
    float* z1 = lds + 4096 + 8192;
    float* sc = lds + 4096 + 16384;
    const bf16_t* U = (const bf16_t*)(p.ws + WS_U);
    const float* filt = (const float*)(p.ws + WS_FILT);
    const float* hn = (const float*)(p.ws + WS_HNORM);
    bf16_t* ymix = (bf16_t*)(p.ws + WS_YMIX);
    for (int u = bid; u < 4096; u += nb) {
        const int c = u >> 3, b0 = (u & 7) * 4;
        if (tid < 128) { const int o = tid >> 6, l = tid & 63; float s = 0.f;
            for (int k = l; k < 256; k += 64) s += hn[(size_t)k * 1024 + o * 512 + c];
            s = wave_sum(s); if (l == 0) sc[o] = 1.0f / s; }
        for (int i = tid; i < 4096; i += NTHREADS) Rf[i] = filt[((size_t)0 * 512 + c) * 4096 + i];
        for (int i = tid; i < 8192; i += NTHREADS) { const int bb = i >> 11, t = i & 2047; zb[i] = bf2f(U[((size_t)(1024 + c) * 32 + b0 + bb) * 2048 + t]); }
        __syncthreads();
#pragma unroll 1
        for (int o = 0; o < 2; ++o) {
            const float* zin = o ? z1 : zb;
            float acc[4][4];
#pragma unroll
            for (int i = 0; i < 4; ++i)
#pragma unroll
                for (int bb = 0; bb < 4; ++bb) acc[i][bb] = 0.f;
            const float* Rb = Rf + 2047 - tid;
#pragma unroll 2
            for (int s = 0; s < 2048; ++s) {
                float r[4], z[4];
#pragma unroll
                for (int i = 0; i < 4; ++i) r[i] = (s - 512 * i + 2047 - tid >= 0) ? Rb[s - 512 * i] : 0.f;
#pragma unroll
                for (int bb = 0; bb < 4; ++bb) z[bb] = zin[bb * 2048 + s];
#pragma unroll
                for (int i = 0; i < 4; ++i)
#pragma unroll
                    for (int bb = 0; bb < 4; ++bb) acc[i][bb] += r[i] * z[bb];
            }
            const float inv = sc[o], dsk = p.hy_d[o * 512 + c];
            if (o == 0) {
#pragma unroll
                for (int i = 0; i < 4; ++i)
#pragma unroll
                    for (int bb = 0; bb < 4; ++bb) { const int t = tid + 512 * i;
                        const float x1 = bf2f(U[((size_t)c * 32 + b0 + bb) * 2048 + t]);
                        z1[bb * 2048 + t] = x1 * (acc[i][bb] * inv + dsk * zb[bb * 2048 + t]); }
                __syncthreads();
                for (int i = tid; i < 4096; i += NTHREADS) Rf[i] = filt[((size_t)1 * 512 + c) * 4096 + i];
                __syncthreads();
            } else {
#pragma unroll
                for (int i = 0; i < 4; ++i)
#pragma unroll
                    for (int bb = 0; bb < 4; ++bb) { const int t = tid + 512 * i;
                        const float x2 = bf2f(U[((size_t)(512 + c) * 32 + b0 + bb) * 2048 + t]);
                        const float y = x2 * (acc[i][bb] * inv + dsk * z1[bb * 2048 + t]);
                        ymix[((size_t)(b0 + bb) * SEQ + t) * 1024 + c] = (bf16_t)(cvt_pk_bf16(y, 0.f) & 0xffffu); }
            }
        }
        __syncthreads();
    }
}

constexpr int HZ_STRIDE = 4112;
constexpr int HZ_F = 32 * HZ_STRIDE;
constexpr int HZ_F1 = 8192 + 64;
constexpr int HZ_SC = HZ_F + 16384 + 128;
__device__ __forceinline__ bf16x8 hy_lda(const unsigned char* q) {
    const unsigned* w = (const unsigned*)q;
    u32x4 v; v.x = w[0]; v.y = w[1]; v.z = w[2]; v.w = w[3];
    return __builtin_bit_cast(bf16x8, v);
}
__device__ __forceinline__ void phase_hyena_mfma(const Params& p, int bid, int nb) {
    const int tid = threadIdx.x, lane = tid & 63, w = tid >> 6, li = lane & 31, hh = lane >> 5;
    unsigned char* Z = g_lds;
    unsigned char* F = g_lds + HZ_F;
    float* sc = (float*)(g_lds + HZ_SC);
    const bf16_t* U = (const bf16_t*)(p.ws + WS_U);
    const float* filt = (const float*)(p.ws + WS_FILT);
    const float* hn = (const float*)(p.ws + WS_HNORM);
    bf16_t* YH = (bf16_t*)(p.ws + WS_YH);
    const int par = (li & 1) ^ 1;
    const unsigned char* fl = F + par * HZ_F1 + 2 * (2047 - li + 8 * hh - par);
    const unsigned char* zl = Z + li * HZ_STRIDE + 16 * hh;
    for (int c = bid; c < 512; c += nb) {
        if (tid < 128) { const int o = tid >> 6, l = tid & 63; float s = 0.f;
            for (int k = l; k < 256; k += 64) s += hn[(size_t)k * 1024 + o * 512 + c];
            s = wave_sum(s); if (l == 0) sc[o] = 1.0f / s; }
        {
            const u32x4* src = (const u32x4*)(U + (size_t)(1024 + c) * 65536);
#pragma unroll
            for (int i = 0; i < 16; ++i) { const int q = tid + 512 * i; *(u32x4*)(Z + (q >> 8) * HZ_STRIDE + (q & 255) * 16) = src[q]; }
        }
#pragma unroll 1
        for (int o = 0; o < 2; ++o) {
            {
                const float* R = filt + ((size_t)o * 512 + c) * 4096;
#pragma unroll
                for (int i = 0; i < 4; ++i) {
                    const int m2 = (tid + 512 * i) * 2;
                    const f32x2 r01 = *(const f32x2*)(R + m2);
                    const float r2 = (m2 + 2 < 4096) ? R[m2 + 2] : 0.f;
                    *(unsigned*)(F + 2 * m2) = cvt_pk_bf16(r01.x, r01.y);
                    *(unsigned*)(F + HZ_F1 + 2 * m2) = cvt_pk_bf16(r01.y, r2);
                }
            }
            __syncthreads();
            const float inv = sc[o], dsk = p.hy_d[o * 512 + c];
            const bf16_t* X = U + ((size_t)(o * 512 + c) * 32 + li) * 2048;
#pragma unroll 1
            for (int pass = 0; pass < 2; ++pass) {
                const int y0 = 8 * w + 4 * pass;
                f32x16 acc[4];
#pragma unroll
                for (int jj = 0; jj < 4; ++jj)
#pragma unroll
                    for (int r = 0; r < 16; ++r) acc[jj][r] = 0.f;
                u32x2 xpre[4][4];
#pragma unroll
                for (int jj = 0; jj < 4; ++jj)
#pragma unroll
                    for (int g = 0; g < 4; ++g) xpre[jj][g] = *(const u32x2*)(X + 32 * (y0 + jj) + 8 * g + 4 * hh);
                bf16x8 Ae[4], Ao[4];
#pragma unroll
                for (int jj = 0; jj < 4; ++jj) { Ae[jj] = hy_lda(fl - 64 * (y0 + jj)); Ao[jj] = hy_lda(fl - 64 * (y0 + jj) + 32); }
                const unsigned char* fnext = fl - 64 * (y0 - 1);
                const unsigned char* zp = zl;
#pragma unroll 1
                for (int pp = 0; pp < 16; ++pp) {
#pragma unroll
                    for (int q = 0; q < 4; ++q) {
                        const bf16x8 be = *(const bf16x8*)(zp);
                        const bf16x8 bo = *(const bf16x8*)(zp + 32);
                        zp += 64;
#pragma unroll
                        for (int jj = 0; jj < 4; ++jj) acc[jj] = __builtin_amdgcn_mfma_f32_32x32x16_bf16(Ae[(jj - q) & 3], be, acc[jj], 0, 0, 0);
                        Ae[(3 - q) & 3] = hy_lda(fnext);
#pragma unroll
                        for (int jj = 0; jj < 4; ++jj) acc[jj] = __builtin_amdgcn_mfma_f32_32x32x16_bf16(Ao[(jj - q) & 3], bo, acc[jj], 0, 0, 0);
                        Ao[(3 - q) & 3] = hy_lda(fnext + 32);
                        fnext += 64;
                    }
                }
#pragma unroll
                for (int jj = 0; jj < 4; ++jj)
#pragma unroll
                    for (int g = 0; g < 4; ++g) {
                        const int t = 32 * (y0 + jj) + 8 * g + 4 * hh;
                        const u32x2 zv = *(const u32x2*)(Z + li * HZ_STRIDE + 2 * t);
                        const u32x2 xv = xpre[jj][g];
                        const float o0 = bflo(xv.x) * (acc[jj][4 * g + 0] * inv + dsk * bflo(zv.x));
                        const float o1 = bfhi(xv.x) * (acc[jj][4 * g + 1] * inv + dsk * bfhi(zv.x));
                        const float o2 = bflo(xv.y) * (acc[jj][4 * g + 2] * inv + dsk * bflo(zv.y));
                        const float o3 = bfhi(xv.y) * (acc[jj][4 * g + 3] * inv + dsk * bfhi(zv.y));
                        u32x2 ov; ov.x = cvt_pk_bf16(o0, o1); ov.y = cvt_pk_bf16(o2, o3);
                        *(u32x2*)(YH + ((size_t)c * 32 + li) * 2048 + t) = ov;
                    }
            }
            __threadfence_block();
            __syncthreads();
            if (o == 0) {
                const u32x4* src = (const u32x4*)(YH + (size_t)c * 65536);
#pragma unroll
                for (int i = 0; i < 16; ++i) { const int q = tid + 512 * i; *(u32x4*)(Z + (q >> 8) * HZ_STRIDE + (q & 255) * 16) = src[q]; }
            }
        }
        __syncthreads();
    }
}

__device__ __forceinline__ void tr_bf16_tile(const bf16_t* __restrict__ src, size_t sld, bf16_t* __restrict__ dst, size_t dld) {
    bf16_t* tile = (bf16_t*)g_lds;
    const int t = threadIdx.x;
    {
        const int i = t >> 3, j8 = (t & 7) * 8;
        const u32x4 v = *(const u32x4*)(src + (size_t)i * sld + j8);
        const unsigned wv[4] = {v.x, v.y, v.z, v.w};
#pragma unroll
        for (int e = 0; e < 4; ++e) { tile[(j8 + 2 * e) * 66 + i] = (bf16_t)(wv[e] & 0xffffu); tile[(j8 + 2 * e + 1) * 66 + i] = (bf16_t)(wv[e] >> 16); }
    }
    __syncthreads();
    {
        const int j = t >> 3, i8 = (t & 7) * 8;
        const unsigned* r = (const unsigned*)(tile + j * 66 + i8);
        u32x4 v; v.x = r[0]; v.y = r[1]; v.z = r[2]; v.w = r[3];
        *(u32x4*)(dst + (size_t)j * dld + i8) = v;
    }
    __syncthreads();
}

__device__ __forceinline__ void tr_bf16_tile_f8(const bf16_t* __restrict__ src, size_t sld, unsigned char* __restrict__ dst, size_t dld, float scale) {
    bf16_t* tile = (bf16_t*)g_lds;
    const int t = threadIdx.x;
    {
        const int i = t >> 3, j8 = (t & 7) * 8;
        const u32x4 v = *(const u32x4*)(src + (size_t)i * sld + j8);
        const unsigned wv[4] = {v.x, v.y, v.z, v.w};
#pragma unroll
        for (int e = 0; e < 4; ++e) { tile[(j8 + 2 * e) * 66 + i] = (bf16_t)(wv[e] & 0xffffu); tile[(j8 + 2 * e + 1) * 66 + i] = (bf16_t)(wv[e] >> 16); }
    }
    __syncthreads();
    {
        const int j = t >> 3, i8 = (t & 7) * 8;
        const unsigned* r = (const unsigned*)(tile + j * 66 + i8);
        const unsigned a = r[0], b = r[1], c = r[2], d = r[3];
        u32x2 w;
        w.x = pk_fp8x4(bflo(a) * scale, bfhi(a) * scale, bflo(b) * scale, bfhi(b) * scale);
        w.y = pk_fp8x4(bflo(c) * scale, bfhi(c) * scale, bflo(d) * scale, bfhi(d) * scale);
        *(u32x2*)(dst + (size_t)j * dld + i8) = w;
    }
    __syncthreads();
}

__device__ __forceinline__ void phase_e(const Params& p, int bid, int nb) {
    const int wid = threadIdx.x >> 6, lane = threadIdx.x & 63;
    const bf16_t* O = (const bf16_t*)(p.ws + WS_O);
    const bf16_t* G = (const bf16_t*)(p.ws + WS_G);
    unsigned char* ymix = p.ws + WS_YMIX;
    {
        const f32x4 ng0 = *(const f32x4*)(p.hg_norm_g + ((8 * lane) & 127)), ng1 = *(const f32x4*)(p.hg_norm_g + ((8 * lane) & 127) + 4);
        const float ng[8] = {ng0[0], ng0[1], ng0[2], ng0[3], ng1[0], ng1[1], ng1[2], ng1[3]};
        const int S = nb * 8;
#define E_LOAD(A, B, Gw, TOK) do { if ((TOK) < T) { const size_t ix_ = (size_t)(TOK) * 512 + 8 * lane; \
            A = *(const u32x4*)(O + ix_); B = *(const u32x4*)(O + (size_t)T * 512 + ix_); Gw = *(const u32x4*)(G + ix_); } } while (0)
#define E_DO(A, B, Gw, TOK) do { if ((TOK) < T) { \
            const unsigned av[4] = {A.x, A.y, A.z, A.w}, bv[4] = {B.x, B.y, B.z, B.w}, gv[4] = {Gw.x, Gw.y, Gw.z, Gw.w}; \
            float o[8], ss = 0.f; \
            _Pragma("unroll") for (int e = 0; e < 4; ++e) { o[2 * e] = bflo(av[e]) + bflo(bv[e]); o[2 * e + 1] = bfhi(av[e]) + bfhi(bv[e]); ss += o[2 * e] * o[2 * e] + o[2 * e + 1] * o[2 * e + 1]; } \
            _Pragma("unroll") for (int off = 1; off < 16; off <<= 1) ss += __shfl_xor(ss, off); \
            const float rs = rsqrtf(ss * (1.0f / 128.0f) + EPS) * YMSCALE; \
            float y[8]; \
            _Pragma("unroll") for (int e = 0; e < 4; ++e) { y[2 * e] = o[2 * e] * rs * ng[2 * e] * bflo(gv[e]); y[2 * e + 1] = o[2 * e + 1] * rs * ng[2 * e + 1] * bfhi(gv[e]); } \
            u32x2 w; w.x = pk_fp8x4(y[0], y[1], y[2], y[3]); w.y = pk_fp8x4(y[4], y[5], y[6], y[7]); \
            *(u32x2*)(ymix + (size_t)(TOK) * 1024 + 512 + 8 * lane) = w; } } while (0)
        u32x4 a0 = {}, b0 = {}, g0 = {}, a1 = {}, b1 = {}, g1 = {};
        int tok = bid * 8 + wid;
        E_LOAD(a0, b0, g0, tok); E_LOAD(a1, b1, g1, tok + S);
#pragma unroll 1
        for (; tok < T; tok += 2 * S) {
            u32x4 na0 = {}, nb0 = {}, ng0 = {}, na1 = {}, nb1 = {}, ng1 = {};
            E_LOAD(na0, nb0, ng0, tok + 2 * S); E_LOAD(na1, nb1, ng1, tok + 3 * S);
            E_DO(a0, b0, g0, tok); E_DO(a1, b1, g1, tok + S);
            a0 = na0; b0 = nb0; g0 = ng0; a1 = na1; b1 = nb1; g1 = ng1;
        }
#undef E_LOAD
#undef E_DO
    }
    __syncthreads();
#if !PROBE_HYENA
    {
        const bf16_t* YH = (const bf16_t*)(p.ws + WS_YH);
        const int t = threadIdx.x;
        for (int q0 = bid; q0 < 8192; q0 += 4 * nb) {
            u32x4 v[4];
#pragma unroll
            for (int k = 0; k < 4; ++k) {
                const int q = q0 + k * nb;
                if (q < 8192) { const int ct = q & 7, tt = (q >> 3) & 31, b = q >> 8; const int i = t >> 3, j8 = (t & 7) * 8;
                    v[k] = *(const u32x4*)(YH + ((size_t)(ct * 64 + i) * 32 + b) * 2048 + tt * 64 + j8); }
            }
#pragma unroll
            for (int k = 0; k < 4; ++k) {
                const int q = q0 + k * nb;
                if (q < 8192) { bf16_t* tile = (bf16_t*)g_lds + k * 64 * 66; const int i = t >> 3, j8 = (t & 7) * 8;
                    const unsigned wv[4] = {v[k].x, v[k].y, v[k].z, v[k].w};
#pragma unroll
                    for (int e = 0; e < 4; ++e) { tile[(j8 + 2 * e) * 66 + i] = (bf16_t)(wv[e] & 0xffffu); tile[(j8 + 2 * e + 1) * 66 + i] = (bf16_t)(wv[e] >> 16); } }
            }
            __syncthreads();
#pragma unroll
            for (int k = 0; k < 4; ++k) {
                const int q = q0 + k * nb;
                if (q < 8192) { const int ct = q & 7, tt = (q >> 3) & 31, b = q >> 8; const bf16_t* tile = (const bf16_t*)g_lds + k * 64 * 66;
                    const int j = t >> 3, i8 = (t & 7) * 8;
                    const unsigned* r = (const unsigned*)(tile + j * 66 + i8);
                    const unsigned a = r[0], b2 = r[1], c = r[2], d = r[3];
                    u32x2 w;
                    w.x = pk_fp8x4(bflo(a) * YMSCALE, bfhi(a) * YMSCALE, bflo(b2) * YMSCALE, bfhi(b2) * YMSCALE);
                    w.y = pk_fp8x4(bflo(c) * YMSCALE, bfhi(c) * YMSCALE, bflo(d) * YMSCALE, bfhi(d) * YMSCALE);
                    *(u32x2*)(ymix + ((size_t)b * SEQ + tt * 64 + j) * 1024 + ct * 64 + i8) = w; }
            }
            __syncthreads();
        }
    }
#endif
}

struct EpiOut {
    const Params* p; int pm, pn;
    __device__ __forceinline__ void operator()(f32x4 (&acc)[2][2][4][2], int wr, int wc, int fr, int fq) const {
        const int b = pm >> 3;
        const float* g1 = (const float*)(p->ws + WS_MOD) + (size_t)b * 6144 + 2 * 1024;
        f32x4 gv[2][2];
#pragma unroll
        for (int bj = 0; bj < 2; ++bj)
#pragma unroll
            for (int n = 0; n < 2; ++n) gv[bj][n] = *(const f32x4*)(g1 + pn * 256 + bj * 128 + wc * 32 + 8 * fq + 4 * n);
#pragma unroll
        for (int ai = 0; ai < 2; ++ai) {
            f32x4 xv[4][2][2];
#pragma unroll
            for (int m = 0; m < 4; ++m) {
                const size_t row = (size_t)pm * 256 + ai * 128 + wr * 64 + m * 16 + fr;
#pragma unroll
                for (int bj = 0; bj < 2; ++bj)
#pragma unroll
                    for (int n = 0; n < 2; ++n) xv[m][bj][n] = *(const f32x4*)(p->x + row * 1024 + pn * 256 + bj * 128 + wc * 32 + 8 * fq + 4 * n);
            }
#pragma unroll
            for (int m = 0; m < 4; ++m) {
                const size_t row = (size_t)pm * 256 + ai * 128 + wr * 64 + m * 16 + fr;
#pragma unroll
                for (int bj = 0; bj < 2; ++bj) {
                    const f32x4 o0 = xv[m][bj][0] + gv[bj][0] * acc[ai][bj][m][0], o1 = xv[m][bj][1] + gv[bj][1] * acc[ai][bj][m][1];
                    u32x4 w; w.x = cvt_pk_bf16(o0[0], o0[1]); w.y = cvt_pk_bf16(o0[2], o0[3]); w.z = cvt_pk_bf16(o1[0], o1[1]); w.w = cvt_pk_bf16(o1[2], o1[3]);
                    *(u32x4*)((unsigned char*)p->out + row * 4096 + (pn * 256 + bj * 128 + wc * 32 + 8 * fq) * 2) = w;
                }
            }
        }
    }
};
__device__ __forceinline__ void phase_f(const Params& p, int bid, int nb) {
    const __amdgpu_buffer_rsrc_t ra = G_RSRC(p.ws + WS_YMIX, (size_t)T * 1024);
    const __amdgpu_buffer_rsrc_t rb = G_RSRC(p.ws + WS_WOUT, (size_t)1024 * 1024);
    unsigned av[4]; av[0] = dense_voff(512); av[1] = av[2] = av[3] = 0u;
    const unsigned bv = av[0];
#ifndef REP_F_GEMM
#define REP_F_GEMM 1
#endif
#ifndef REP_F_CONV
#define REP_F_CONV 1
#endif
    {
        struct Src {
            __amdgpu_buffer_rsrc_t ra, rb; unsigned dv; int x, r, R, NX;
            __device__ __forceinline__ bool operator()(int i, GU& u) const {
                const int j = r + R * i;
                if (j >= 1024 / NX) return false;
                const int pm = x + NX * (j >> 2), pn = j & 3;
                u.ra = ra; u.rb = rb; u.av[0] = dv; u.av[1] = u.av[2] = u.av[3] = 0u;
                u.asoff = (unsigned)(pm * 256) * 1024u; u.bsoff = (unsigned)(pn * 256) * 1024u; u.t0 = pm; u.t1 = pn; u.t2 = 0;
                return true;
            }
            __device__ __forceinline__ void after(int) const {}
        } sf;
        const int NX = (nb & 7) == 0 ? 8 : 1;
        sf.ra = ra; sf.rb = rb; sf.dv = bv; sf.NX = NX; sf.x = bid % NX; sf.r = bid / NX; sf.R = nb / NX;
        struct Epi {
            const Params* p;
            __device__ __forceinline__ void operator()(f32x4 (&acc)[2][2][4][2], const GU& u, int wr, int wc, int fr, int fq) const {
                EpiOut e; e.p = p; e.pm = u.t0; e.pn = u.t1; e(acc, wr, wc, fr, fq);
            }
        } ef; ef.p = &p;
        gemm_stream<false, E8_2M5, E8_2M3>(sf, ef, 1024u, 1024u, dense_voff_perm(512), 8);
    }
    __syncthreads();
    unsigned char* W1 = p.ws + WS_W1T; unsigned char* W2 = p.ws + WS_W2T;
#pragma unroll 1
    for (int repc_ = 0; repc_ < REP_F_CONV; ++repc_)
    {
        float* tile = (float*)g_lds;
        const int t = threadIdx.x;
        const int lr = t >> 6, lc4 = (t & 63) * 4;
        auto unit_src = [&](int q, const float*& s, int& C, int& r0, int& c0) {
            const int e = q / 48, tt = q % 48;
            if (tt < 16) { s = e < 256 ? p.ew_gate + (size_t)e * 262144 : p.sw_gate; C = 256; r0 = tt * 64; c0 = 0; }
            else if (tt < 32) { s = e < 256 ? p.ew_up + (size_t)e * 262144 : p.sw_up; C = 256; r0 = (tt - 16) * 64; c0 = 0; }
            else { const int r = tt - 32; s = e < 256 ? p.ew_down + (size_t)e * 262144 : p.sw_down; C = 1024; r0 = (r >> 2) * 64; c0 = (r & 3) * 256; }
        };
        f32x4 v[8];
        int q = bid;
        if (q < 257 * 48) { const float* s; int C, r0, c0; unit_src(q, s, C, r0, c0);
#pragma unroll
            for (int i = 0; i < 8; ++i) v[i] = *(const f32x4*)(s + (size_t)(r0 + lr + 8 * i) * C + c0 + lc4); }
        for (; q < 257 * 48; q += nb) {
#pragma unroll
            for (int i = 0; i < 8; ++i) *(f32x4*)(tile + (lr + 8 * i) * 260 + lc4) = v[i];
            __syncthreads();
            if (q + nb < 257 * 48) { const float* s; int C, r0, c0; unit_src(q + nb, s, C, r0, c0);
#pragma unroll
                for (int i = 0; i < 8; ++i) v[i] = *(const f32x4*)(s + (size_t)(r0 + lr + 8 * i) * C + c0 + lc4); }
            {
                const int e = q / 48, tt = q % 48;
                unsigned char* dst; int dld, r0, c0, add; float scale;
                if (tt < 32) { dst = W1 + (size_t)e * 524288; dld = 1024; r0 = (tt & 15) * 64; c0 = 0; add = (tt < 16) ? 0 : 128; scale = WSCALE; }
                else { const int r = tt - 32; dst = W2 + (size_t)e * 262144; dld = 256; r0 = (r >> 2) * 64; c0 = (r & 3) * 256; add = -1; scale = W2SCALE; }
#pragma unroll
                for (int qq = 0; qq < 4; ++qq) {
                    const int cc = qq * 64 + (t >> 3), rr = (t & 7) * 8;
                    float w8[8];
#pragma unroll
                    for (int k = 0; k < 8; ++k) w8[k] = tile[(rr + k) * 260 + cc] * scale;
                    u32x2 w; w.x = pk_fp8x4(w8[0], w8[1], w8[2], w8[3]); w.y = pk_fp8x4(w8[4], w8[5], w8[6], w8[7]);
                    const int n = c0 + cc;
                    const int drow = add < 0 ? n : (n >> 7) * 256 + add + (n & 127);
                    *(u32x2*)(dst + (size_t)drow * dld + r0 + rr) = w;
                }
            }
            __syncthreads();
        }
    }
}

struct EpiLogits {
    const Params* p; int pm;
    __device__ __forceinline__ void operator()(f32x4 (&acc)[2][2][4][2], int wr, int wc, int fr, int fq) const {
        float* LG = (float*)(p->ws + WS_LG);
#pragma unroll
        for (int ai = 0; ai < 2; ++ai)
#pragma unroll
            for (int m = 0; m < 4; ++m) {
                const size_t row = (size_t)pm * 256 + ai * 128 + wr * 64 + m * 16 + fr;
#pragma unroll
                for (int bj = 0; bj < 2; ++bj)
#pragma unroll
                    for (int n = 0; n < 2; ++n) *(f32x4*)(LG + row * 256 + bj * 128 + wc * 32 + n * 16 + 4 * fq) = acc[ai][bj][m][n];
            }
    }
};
__device__ __forceinline__ float sel4(const float (&a)[4], int j) { return j == 0 ? a[0] : (j == 1 ? a[1] : (j == 2 ? a[2] : a[3])); }
__device__ __forceinline__ void phase_h(const Params& p, int bid, int nb) {
    const __amdgpu_buffer_rsrc_t ra = G_RSRC(p.ws + WS_HX2, (size_t)T * 2048);
    const __amdgpu_buffer_rsrc_t rb = G_RSRC(p.ws + WS_WR, (size_t)256 * 2048);
    const float* LG = (const float*)(p.ws + WS_LG);
    unsigned* cnt = (unsigned*)(p.ws + WS_CNT);
    u32x2* list = (u32x2*)(p.ws + WS_LIST);
    for (int u = bid; u < 256; u += nb) {
        EpiLogits e; e.p = &p; e.pm = u;
        unsigned av[4]; av[0] = dense_voff(1024); av[1] = av[2] = av[3] = 0u;
        gemm_unit<false, false, 0, 0>(ra, av, (unsigned)(u * 256) * 2048u, 2048u, rb, av[0], 0u, 2048u, 16, e);
    }
    __threadfence_block();
    __syncthreads();
    const int wid = threadIdx.x >> 6, lane = threadIdx.x & 63;
    unsigned* lcnt = (unsigned*)g_lds;
    unsigned* lbase = (unsigned*)g_lds + 256;
    unsigned short* lexp = (unsigned short*)(g_lds + 2048);
    unsigned short* lrk = (unsigned short*)(g_lds + 6144);
    float* lw = (float*)(g_lds + 10240);
    for (int u = bid; u < 256; u += nb) {
        if (threadIdx.x < 256) lcnt[threadIdx.x] = 0u;
        __syncthreads();
        const f32x4 rbias = *(const f32x4*)(p.router_bias + 4 * lane);
        f32x4 lgn = *(const f32x4*)(LG + (size_t)(u * 256 + wid * 32) * 256 + 4 * lane);
        for (int rr = 0; rr < 32; ++rr) {
            const int row = u * 256 + wid * 32 + rr;
            const f32x4 lg = lgn;
            if (rr + 1 < 32) lgn = *(const f32x4*)(LG + (size_t)(row + 1) * 256 + 4 * lane);
            float sc[4], val[4];
#pragma unroll
            for (int i = 0; i < 4; ++i) { sc[i] = __builtin_amdgcn_rcpf(1.0f + __expf(-lg[i])); val[i] = sc[i] + rbias[i]; }
            float m1 = -INFINITY, m2 = -INFINITY;
#pragma unroll
            for (int i = 0; i < 4; ++i) { if (val[i] > m1) { m2 = m1; m1 = val[i]; } else if (val[i] > m2) m2 = val[i]; }
#pragma unroll
            for (int off = 1; off < 8; off <<= 1) {
                const float o1 = __shfl_xor(m1, off), o2 = __shfl_xor(m2, off);
                const float n1 = fmaxf(m1, o1), n2 = fmaxf(fminf(m1, o1), fmaxf(m2, o2));
                m1 = n1; m2 = n2;
            }
            const float gs = m1 + m2;
            const int g = lane >> 3;
            int rank = 0;
#pragma unroll
            for (int gg = 0; gg < 8; ++gg) { const float sg = __int_as_float(__builtin_amdgcn_readlane(__float_as_int(gs), gg * 8)); rank += (sg > gs || (sg == gs && gg < g)) ? 1 : 0; }
            unsigned key[4];
#pragma unroll
            for (int i = 0; i < 4; ++i) {
                const unsigned bits = __float_as_uint(val[i]);
                const unsigned mono = bits ^ ((bits >> 31) ? 0xFFFFFFFFu : 0x80000000u);
                key[i] = rank >= 4 ? 0u : ((mono & 0xFFFFFF00u) | (unsigned)(255 - (4 * lane + i)));
            }
            float sumw = 0.f, my_s = 0.f; int my_e = 0;
#pragma unroll
            for (int k = 0; k < 8; ++k) {
                unsigned kb = max(max(key[0], key[1]), max(key[2], key[3]));
#pragma unroll
                for (int off = 32; off > 0; off >>= 1) kb = max(kb, (unsigned)__shfl_xor((int)kb, off));
                const int be = 255 - (int)(kb & 255u);
                const int ol = __builtin_amdgcn_readfirstlane(be >> 2), oj = be & 3;
                const float sk = __int_as_float(__builtin_amdgcn_readlane(__float_as_int(sel4(sc, oj)), ol));
                if (lane == ol) { if (oj == 0) key[0] = 0u; else if (oj == 1) key[1] = 0u; else if (oj == 2) key[2] = 0u; else key[3] = 0u; }
                sumw += sk;
                if (lane == k) { my_e = be; my_s = sk; }
            }
            if (lane < 8) {
                const unsigned lrank = atomicAdd(&lcnt[my_e], 1u);
                const int al = (wid * 32 + rr) * 8 + lane;
                lexp[al] = (unsigned short)my_e; lrk[al] = (unsigned short)lrank;
                lw[al] = 2.5f * my_s / sumw * YSCALE;
            }
        }
        __syncthreads();
        if (threadIdx.x < 256) { const unsigned c = lcnt[threadIdx.x]; lbase[threadIdx.x] = c ? atomicAdd(&cnt[threadIdx.x * 32], c) : 0u; }
        __syncthreads();
#pragma unroll
        for (int i = 0; i < 4; ++i) {
            const int al = threadIdx.x + 512 * i;
            const int e = lexp[al];
            u32x2 ent; ent.x = (unsigned)(u * 2048 + al); ent.y = __float_as_uint(lw[al]);
            list[(size_t)e * 65536 + lbase[e] + lrk[al]] = ent;
        }
        __syncthreads();
    }
}

constexpr int LDS_PRE = 131072;
constexpr int LDS_ROWINFO = 131072 + 2048;
constexpr int LDS_ROWSCALE = 131072 + 4096;
constexpr int LDS_ECNT = 131072 + 6144;
__device__ __forceinline__ int build_tile_prefix(const Params& p) {
    int* pre = (int*)(g_lds + LDS_PRE);
    const unsigned* cnt = (const unsigned*)(p.ws + WS_CNT);
    __syncthreads();
    if (threadIdx.x == 0) {
        int s = 0;
        int* ec = (int*)(g_lds + LDS_ECNT);
        for (int e = 0; e < 256; ++e) { const unsigned c = cnt[e * 32]; ec[e] = (int)c; pre[e] = s; s += (int)((c + 255u) >> 8); }
        pre[256] = s; s += 256; pre[257] = s;
    }
    __syncthreads();
    return pre[257];
}
__device__ __forceinline__ int build_tile_prefix_xcd(const Params& p, int x) {
    int* pre = (int*)(g_lds + LDS_PRE);
    const unsigned* cnt = (const unsigned*)(p.ws + WS_CNT);
    __syncthreads();
    if (threadIdx.x == 0) {
        int s = 0;
        int* ec = (int*)(g_lds + LDS_ECNT);
        for (int k = 0; k < 32; ++k) { const unsigned c = cnt[(x + 8 * k) * 32]; ec[k] = (int)c; pre[k] = s; s += (int)((c + 255u) >> 8); }
        pre[32] = s; pre[33] = s + 32;
    }
    __syncthreads();
    return pre[33];
}
__device__ __forceinline__ void decode_rt_xcd(const Params& p, int x, int rtl, int& e, int& tile, int& cnt_e) {
    const int* pre = (const int*)(g_lds + LDS_PRE);
    if (rtl >= pre[32]) { e = 256; tile = 32 * x + (rtl - pre[32]); cnt_e = T; return; }
    int lo = 0, hi = 31;
    while (lo < hi) { const int mid = (lo + hi + 1) >> 1; if (pre[mid] <= rtl) lo = mid; else hi = mid - 1; }
    e = x + 8 * lo; tile = rtl - pre[lo];
    cnt_e = ((const int*)(g_lds + LDS_ECNT))[lo];
}
__device__ __forceinline__ void decode_rt(const Params& p, int rt, int& e, int& tile, int& cnt_e) {
    const int* pre = (const int*)(g_lds + LDS_PRE);
    int lo = 0, hi = 256;
    while (lo < hi) { const int mid = (lo + hi + 1) >> 1; if (pre[mid] <= rt) lo = mid; else hi = mid - 1; }
    e = lo; tile = rt - pre[lo];
    cnt_e = e < 256 ? ((const int*)(g_lds + LDS_ECNT))[e] : T;
}
__device__ __forceinline__ void load_rowinfo_regs(const Params& p, bool xo, int x, int rt, int& a, float& sc) {
    int e, tile, cnt_e;
    if (xo) decode_rt_xcd(p, x, rt, e, tile, cnt_e); else decode_rt(p, rt, e, tile, cnt_e);
    a = -1; sc = 0.f;
    if (threadIdx.x < 256) {
        const int idx = tile * 256 + threadIdx.x;
        if (idx < cnt_e) {
            if (e < 256) { const u32x2 ent = ((const u32x2*)(p.ws + WS_LIST))[(size_t)e * 65536 + idx]; a = (int)ent.x; sc = __uint_as_float(ent.y); }
            else { a = NA + idx; sc = YSCALE; }
        }
    }
}
__device__ __forceinline__ void store_rowinfo_regs(int a, float sc) {
    __syncthreads();
    if (threadIdx.x < 256) { ((int*)(g_lds + LDS_ROWINFO))[threadIdx.x] = a; ((float*)(g_lds + LDS_ROWSCALE))[threadIdx.x] = sc; }
    __syncthreads();
}
struct EpiE1 {
    const Params* p; int pn;
    __device__ __forceinline__ void operator()(f32x4 (&acc)[2][2][4][2], int wr, int wc, int fr, int fq) const {
        const int* rowinfo = (const int*)(g_lds + LDS_ROWINFO);
        unsigned char* tile = g_lds;
#pragma unroll
        for (int ai = 0; ai < 2; ++ai)
#pragma unroll
            for (int m = 0; m < 4; ++m) {
                const int row = ai * 128 + wr * 64 + m * 16 + fr;
#pragma unroll
                for (int n = 0; n < 2; ++n) {
                    const f32x4 g = acc[ai][0][m][n], uu = acc[ai][1][m][n];
                    *(unsigned*)(tile + row * 144 + wc * 32 + n * 16 + 4 * fq) =
                        pk_fp8x4(siluf_(g[0]) * uu[0] * HSCALE, siluf_(g[1]) * uu[1] * HSCALE, siluf_(g[2]) * uu[2] * HSCALE, siluf_(g[3]) * uu[3] * HSCALE);
                }
            }
        __syncthreads();
        unsigned char* H = p->ws + WS_H;
        int tid = threadIdx.x; asm volatile("" : "+v"(tid));
#pragma unroll
        for (int i = 0; i < 4; ++i) {
            const int idx = tid + 512 * i, row = idx >> 3, ch = idx & 7;
            const int a = rowinfo[row];
            if (a >= 0) *(u32x4*)(H + (size_t)a * 256 + pn * 128 + ch * 16) = *(const u32x4*)(tile + row * 144 + ch * 16);
        }
        __syncthreads();
    }
};
struct EpiE2 {
    const Params* p; int pn;
    __device__ __forceinline__ void operator()(f32x4 (&acc)[2][2][4][2], int wr, int wc, int fr, int fq) const {
        const int* rowinfo = (const int*)(g_lds + LDS_ROWINFO);
        unsigned char* tile = g_lds;
#pragma unroll
        for (int ai = 0; ai < 2; ++ai)
#pragma unroll
            for (int m = 0; m < 4; ++m) {
                const int row = ai * 128 + wr * 64 + m * 16 + fr;
                const float wg = ((const float*)(g_lds + LDS_ROWSCALE))[row];
#pragma unroll
                for (int bj = 0; bj < 2; ++bj)
#pragma unroll
                    for (int n = 0; n < 2; ++n) {
                        const f32x4 v = acc[ai][bj][m][n];
                        *(unsigned*)(tile + row * 272 + bj * 128 + wc * 32 + n * 16 + 4 * fq) = pk_fp8x4(v[0] * wg, v[1] * wg, v[2] * wg, v[3] * wg);
                    }
            }
        __syncthreads();
        int tid = threadIdx.x; asm volatile("" : "+v"(tid));
#pragma unroll
        for (int i = 0; i < 8; ++i) {
            const int idx = tid + 512 * i, row = idx >> 4, ch = idx & 15;
            const int a = rowinfo[row];
            if (a >= 0) {
                unsigned char* dst = a < NA ? p->ws + WS_Y + (size_t)a * 1024 : p->ws + WS_YSH + (size_t)(a - NA) * 1024;
                *(u32x4*)(dst + pn * 256 + ch * 16) = *(const u32x4*)(tile + row * 272 + ch * 16);
            }
        }
        __syncthreads();
    }
};
constexpr int LDS_TAB = 131072 + 2048;
struct SrcI {
    const Params* p; __amdgpu_buffer_rsrc_t ra; bool xo; int x, u0, us, nu, R0, C0, tid, pa;
    __device__ __forceinline__ bool dec(int i, int& e, int& tile, int& cnt_e, int& pn) const {
        const int u = u0 + us * i; if (u >= nu) return false;
        pn = u & 1;
        if (xo) decode_rt_xcd(*p, x, u >> 1, e, tile, cnt_e); else decode_rt(*p, u >> 1, e, tile, cnt_e);
        return true;
    }
    __device__ __forceinline__ void load_pa(int i) {
        int e, tile, cnt_e, pn; pa = -1;
        if (dec(i, e, tile, cnt_e, pn) && tid < 256) {
            const int idx = tile * 256 + tid;
            if (idx < cnt_e) pa = e < 256 ? (int)((const unsigned*)(p->ws + WS_LIST))[((size_t)e * 65536 + idx) * 2] : NA + idx;
        }
    }
    __device__ __forceinline__ void store_tab(int i) const { if (tid < 256) ((int*)(g_lds + LDS_TAB))[(i & 3) * 256 + tid] = pa; }
    __device__ __forceinline__ void after(int j) const { store_tab(j + 3); }
    __device__ __forceinline__ bool operator()(int i, GU& u) {
        int e, tile, cnt_e, pn;
        const bool ok = dec(i, e, tile, cnt_e, pn);
        if (ok) {
            const int* tab = (const int*)(g_lds + LDS_TAB) + (i & 3) * 256;
#pragma unroll
            for (int k = 0; k < 4; ++k) {
                const int a = tab[(k >> 1) * 128 + R0 + 64 * (k & 1)];
                const unsigned tok = a < 0 ? 0u : (a >= NA ? (unsigned)(a - NA) : (unsigned)a >> 3);
                u.av[k] = tok * 1024u + (unsigned)C0 * 2u;
            }
            u.ra = ra; u.rb = G_RSRC(p->ws + WS_W1T + (size_t)e * 524288, 524288);
            u.asoff = 0u; u.bsoff = (unsigned)(pn * 256) * 1024u;
            u.t0 = i & 3; u.t1 = pn; u.t2 = 0;
        }
        if (i > 0) load_pa(i + 2);
        return ok;
    }
};
struct EpiE1S {
    const Params* p;
    __device__ __forceinline__ void operator()(f32x4 (&acc)[2][2][4][2], const GU& u, int wr, int wc, int fr, int fq) const {
        const int* tab = (const int*)(g_lds + LDS_TAB) + u.t0 * 256;
        unsigned char* H = p->ws + WS_H;
        const int pn = u.t1;
#pragma unroll
        for (int ai = 0; ai < 2; ++ai)
#pragma unroll
            for (int m = 0; m < 4; ++m) {
                const int a = tab[ai * 128 + wr * 64 + m * 16 + fr];
                if (a >= 0) {
                    const f32x4 g0 = acc[ai][0][m][0], g1 = acc[ai][0][m][1], u0 = acc[ai][1][m][0], u1 = acc[ai][1][m][1];
                    u32x2 w;
                    w.x = pk_fp8x4(siluf_(g0[0]) * u0[0] * HSCALE, siluf_(g0[1]) * u0[1] * HSCALE, siluf_(g0[2]) * u0[2] * HSCALE, siluf_(g0[3]) * u0[3] * HSCALE);
                    w.y = pk_fp8x4(siluf_(g1[0]) * u1[0] * HSCALE, siluf_(g1[1]) * u1[1] * HSCALE, siluf_(g1[2]) * u1[2] * HSCALE, siluf_(g1[3]) * u1[3] * HSCALE);
                    *(u32x2*)(H + (size_t)a * 256 + pn * 128 + wc * 32 + 8 * fq) = w;
                }
            }
    }
};
__device__ __forceinline__ void phase_i(const Params& p, int bid, int nb) {
    const bool xo = (nb & 7) == 0;
    const int x = bid & 7;
    const int nrt = xo ? build_tile_prefix_xcd(p, x) : build_tile_prefix(p);
    SrcI sf; sf.p = &p; sf.ra = G_RSRC(p.ws + WS_HX2F8, (size_t)T * 1024); sf.xo = xo; sf.x = x;
    sf.u0 = xo ? (bid >> 3) : bid; sf.us = xo ? (nb >> 3) : nb; sf.nu = nrt * 2; sf.tid = threadIdx.x;
    g_thread_rc(sf.R0, sf.C0);
    sf.load_pa(0); sf.store_tab(0); sf.load_pa(1); sf.store_tab(1); sf.load_pa(2); sf.store_tab(2);
    __syncthreads();
    EpiE1S ef; ef.p = &p;
    gemm_stream<true, E8_2M5, E8_1>(sf, ef, 0u, 1024u, dense_voff_perm(512), 8);
    __syncthreads();
}
constexpr int LDS_YSTG = 131072 + 8192;
constexpr size_t WS_DUMP = 512 * 1024;
__device__ __forceinline__ void phase_j(const Params& p, int bid, int nb) {
    const bool xo = (nb & 7) == 0;
    const int x = bid & 7;
    const int nrt = xo ? build_tile_prefix_xcd(p, x) : build_tile_prefix(p);
    const int* rowinfo = (const int*)(g_lds + LDS_ROWINFO);
    const float* rowscale = (const float*)(g_lds + LDS_ROWSCALE);
    bf16_t* shm = (bf16_t*)g_lds;
    constexpr int SCW = E8_2M4, SCA = E8_2M3;
    const __amdgpu_buffer_rsrc_t ra = G_RSRC(p.ws + WS_H, (size_t)(NA + T) * 256);
    const int rt0 = xo ? (bid >> 3) : bid, rts = xo ? (nb >> 3) : nb;
    if (rt0 >= nrt) return;
    int a_n = -1; float sc_n = 0.f;
    load_rowinfo_regs(p, xo, x, rt0, a_n, sc_n);
    store_rowinfo_regs(a_n, sc_n);
    int tz0 = threadIdx.x; asm volatile("" : "+v"(tz0));
    int R0, C0; g_stage_rc(tz0 * 16, R0, C0);
    const int wbase = __builtin_amdgcn_readfirstlane((tz0 >> 6) * 1024);
    const unsigned bv = (unsigned)((64 * (R0 >> 5) + 16 * ((R0 & 15) >> 2) + 4 * ((R0 >> 4) & 1) + (R0 & 3)) * 256 + C0 * 2);
#define J_STAGE_A(tab_) do { _Pragma("unroll") for (int h = 0; h < 2; ++h) { \
            int a0 = rowinfo[(tab_) * 256 + h * 128 + R0], a1 = rowinfo[(tab_) * 256 + h * 128 + R0 + 64]; \
            if (a0 < 0) a0 = 0; if (a1 < 0) a1 = 0; \
            const unsigned v0 = (unsigned)a0 * 256u + (unsigned)C0 * 2u, v1 = (unsigned)a1 * 256u + (unsigned)C0 * 2u; \
            _Pragma("unroll") for (int kt = 0; kt < 2; ++kt) { G_DMA(G_SA(kt, h), ra, v0, (unsigned)kt * 128u); G_DMA((char*)G_SA(kt, h) + 8192, ra, v1, (unsigned)kt * 128u); } } } while (0)
#define J_STAGE_B(rb_, pn_) do { _Pragma("unroll") for (int h = 0; h < 2; ++h) _Pragma("unroll") for (int kt = 0; kt < 2; ++kt) { \
            G_DMA(G_SB(kt, h), rb_, bv, (unsigned)((pn_) * 256 + h * 8) * 256u + (unsigned)kt * 128u); \
            G_DMA((char*)G_SB(kt, h) + 8192, rb_, bv, (unsigned)((pn_) * 256 + h * 8 + 128) * 256u + (unsigned)kt * 128u); } } while (0)
    __amdgpu_buffer_rsrc_t rb;
    { int e, tile, cnt_e; if (xo) decode_rt_xcd(p, x, rt0, e, tile, cnt_e); else decode_rt(p, rt0, e, tile, cnt_e);
      rb = G_RSRC(p.ws + WS_W2T + (size_t)e * 262144, 262144); }
    J_STAGE_A(0); J_STAGE_B(rb, 0);
    if (rt0 + rts < nrt) load_rowinfo_regs(p, xo, x, rt0 + rts, a_n, sc_n);
    int cur = 0;
#pragma unroll 1
    for (int rt = rt0; rt < nrt; rt += rts, cur ^= 1) {
        const bool has_next = rt + rts < nrt;
        __amdgpu_buffer_rsrc_t rbn = rb;
        if (has_next) { int e, tile, cnt_e; if (xo) decode_rt_xcd(p, x, rt + rts, e, tile, cnt_e); else decode_rt(p, rt + rts, e, tile, cnt_e);
                        rbn = G_RSRC(p.ws + WS_W2T + (size_t)e * 262144, 262144); }
        int tz = threadIdx.x; asm volatile("" : "+v"(tz));
        const int wid = tz >> 6, lane = tz & 63, wr = wid >> 2, wc = wid & 3, fr = lane & 15, fq = lane >> 4;
#pragma unroll 1
        for (int pn = 0; pn < 4; ++pn) {
            if (pn == 0 && rt == rt0) asm volatile("s_waitcnt vmcnt(0)" ::: "memory"); else asm volatile("s_waitcnt vmcnt(8)" ::: "memory");
            __syncthreads();
            f32x4 acc[2][2][4][2];
            {
                i32x8 Aa[4], Ba[2], Bb[2];
                G_LDA8(Aa, 0, 0); G_LDB8(Ba, 0, 0); G_LDB8(Bb, 0, 1);
                G_WAIT_L(4); G_SCHED; G_MMA8F(0, 0, Aa, Ba);
                G_WAIT_L(0); G_SCHED; G_MMA8F(0, 1, Aa, Bb); G_SCHED;
                G_LDA8(Aa, 0, 1);
                G_WAIT_L(0); G_SCHED; G_MMA8F(1, 0, Aa, Ba); G_SCHED;
                G_LDB8(Ba, 1, 0);
                G_SCHED; G_MMA8F(1, 1, Aa, Bb); G_SCHED;
                G_LDA8(Aa, 1, 0); G_LDB8(Bb, 1, 1);
                G_WAIT_L(4); G_SCHED; G_MMA8(0, 0, Aa, Ba);
                G_WAIT_L(0); G_SCHED; G_MMA8(0, 1, Aa, Bb); G_SCHED;
                G_LDA8(Aa, 1, 1);
                G_WAIT_L(0); G_SCHED; G_MMA8(1, 0, Aa, Ba); G_MMA8(1, 1, Aa, Bb);
            }
            asm volatile("s_nop 15\n\ts_nop 15" ::: "memory");
            __syncthreads();
            if (pn == 1 && has_next && threadIdx.x < 256) {
                ((int*)(g_lds + LDS_ROWINFO))[(cur ^ 1) * 256 + threadIdx.x] = a_n; ((float*)(g_lds + LDS_ROWSCALE))[(cur ^ 1) * 256 + threadIdx.x] = sc_n;
            }
            if (pn < 3) J_STAGE_B(rb, pn + 1);
            else if (has_next) {
                J_STAGE_A(cur ^ 1); J_STAGE_B(rbn, 0);
                if (rt + 2 * rts < nrt) load_rowinfo_regs(p, xo, x, rt + 2 * rts, a_n, sc_n);
            }
            {
                int ty = threadIdx.x; asm volatile("" : "+v"(ty));
                const int fr_ = ty & 15, fq_ = (ty >> 4) & 3;
#pragma unroll
                for (int ai = 0; ai < 2; ++ai)
#pragma unroll
                    for (int m = 0; m < 4; ++m) {
                        const int row = ai * 128 + wr * 64 + m * 16 + fr_;
                        const float wg = rowscale[cur * 256 + row];
                        const int a = rowinfo[cur * 256 + row];
                        unsigned char* dst = a < 0 ? p.ws + WS_DUMP : (a < NA ? p.ws + WS_Y + (size_t)a * 1024 : p.ws + WS_YSH + (size_t)(a - NA) * 1024);
                        const f32x4 v0 = acc[ai][0][m][0], v1 = acc[ai][0][m][1], v2 = acc[ai][1][m][0], v3 = acc[ai][1][m][1];
                        u32x4 w; w.x = pk_fp8x4(v0[0] * wg, v0[1] * wg, v0[2] * wg, v0[3] * wg); w.y = pk_fp8x4(v1[0] * wg, v1[1] * wg, v1[2] * wg, v1[3] * wg);
                        w.z = pk_fp8x4(v2[0] * wg, v2[1] * wg, v2[2] * wg, v2[3] * wg); w.w = pk_fp8x4(v3[0] * wg, v3[1] * wg, v3[2] * wg, v3[3] * wg);
                        *(u32x4*)(dst + pn * 256 + wc * 64 + 16 * fq_) = w;
                    }
            }
        }
        rb = rbn;
    }
#undef J_STAGE_A
#undef J_STAGE_B
}

__device__ __forceinline__ void phase_k(const Params& p, int bid, int nb) {
    const int wid = threadIdx.x >> 6, lane = threadIdx.x & 63;
    const float* mod = (const float*)(p.ws + WS_MOD);
    for (int tile = bid; tile * 256 < T; tile += nb) {
    const int bt = (tile * 256) >> 11;
    f32x4 g2v[4], fgv[4];
#pragma unroll
    for (int i = 0; i < 4; ++i) { g2v[i] = *(const f32x4*)(mod + (size_t)bt * 6144 + 5 * 1024 + 16 * lane + 4 * i); fgv[i] = *(const f32x4*)(p.final_g + 16 * lane + 4 * i); }
#pragma unroll 1
    for (int kk = 0; kk < 32; ++kk) {
        const int tok = tile * 256 + wid + 8 * kk;
        float s[16];
#pragma unroll
        for (int i = 0; i < 16; ++i) s[i] = 0.f;
#pragma unroll
        for (int k = 0; k < 9; ++k) {
            const unsigned char* src = k < 8 ? p.ws + WS_Y + ((size_t)tok * 8 + k) * 1024 : p.ws + WS_YSH + (size_t)tok * 1024;
            const u32x4 w = *(const u32x4*)(src + 16 * lane);
            acc_fp8x4(w.x, s[0], s[1], s[2], s[3]); acc_fp8x4(w.y, s[4], s[5], s[6], s[7]);
            acc_fp8x4(w.z, s[8], s[9], s[10], s[11]); acc_fp8x4(w.w, s[12], s[13], s[14], s[15]);
        }
        float* xr = p.out + (size_t)tok * 1024 + 16 * lane;
        const u32x4 xb0 = *(const u32x4*)((const unsigned char*)(p.out + (size_t)tok * 1024) + 32 * lane), xb1 = *(const u32x4*)((const unsigned char*)(p.out + (size_t)tok * 1024) + 32 * lane + 16);
        const unsigned xb[8] = {xb0.x, xb0.y, xb0.z, xb0.w, xb1.x, xb1.y, xb1.z, xb1.w};
        f32x4 xv[4]; float ss = 0.f;
#pragma unroll
        for (int i = 0; i < 4; ++i) {
            const f32x4 x1 = (f32x4){__uint_as_float(xb[2 * i] << 16), __uint_as_float(xb[2 * i] & 0xffff0000u), __uint_as_float(xb[2 * i + 1] << 16), __uint_as_float(xb[2 * i + 1] & 0xffff0000u)};
            const f32x4 gv = g2v[i];
#pragma unroll
            for (int j = 0; j < 4; ++j) { const float v = x1[j] + gv[j] * (s[4 * i + j] * (1.0f / YSCALE)); xv[i][j] = v; ss += v * v; }
        }
        ss = wave_sum(ss);
        float rs = rsqrtf(ss * (1.0f / 1024.0f) + EPS);
#if PROBE_HYENA || PROBE_HGRN
        { const unsigned* df = (const unsigned*)(p.ws + WS_DIFF);
          float fac = 1.0f;
#if PROBE_HGRN == 7
          if (df[0] > 100u) fac += 0.5f;
          if (df[1] > 100u) fac += 1.0f;
          if (df[2] > 100u) fac += 2.0f;
          if (df[3] > 100u) fac += 4.0f;
#else
          if (df[0] > 10000u) fac += 0.5f;
          if (df[1] > 335000u) fac += 1.0f;
          if (df[2] > 10000u) fac += 2.0f;
          if (df[3] > 10000u) fac += 4.0f;
#endif
          rs *= fac; }
#endif
#pragma unroll
        for (int i = 0; i < 4; ++i) { *(f32x4*)(xr + 4 * i) = xv[i] * rs * fgv[i]; }
    }
    }
}

__device__ __forceinline__ void probe_trash_lds() {
    __syncthreads();
    for (int i = threadIdx.x; i < (LDS_BYTES - 16) / 4; i += NTHREADS) ((unsigned*)g_lds)[i] = 0xFFFFFFFFu;
    __syncthreads();
}
#if PROBE_HGRN
__device__ __forceinline__ void probe_hgrn_compare(const Params& p, int bid, int nb) {
    const bf16_t* A = (const bf16_t*)(p.ws + WS_O);
    const bf16_t* R = (const bf16_t*)(p.ws + WS_O2);
    unsigned bad[4] = {0u, 0u, 0u, 0u};
    for (size_t i = (size_t)bid * NTHREADS + threadIdx.x; i < (size_t)2 * T * 512; i += (size_t)nb * NTHREADS) {
        const float a = bf2f(A[i]), r = bf2f(R[i]);
        const int dir = (int)(i / ((size_t)T * 512)); const int t = (int)((i / 512) & 2047);
        if (!(fabsf(a - r) <= 0.03f * fabsf(r) + 0.01f)) {
            if (dir == 0 && t < 64) ++bad[0];
            if (dir == 0) ++bad[1];
            if (dir == 1 && t >= 1984) ++bad[2];
            if (dir == 0 && t >= 64 && t < 128) ++bad[3];
        }
    }
#pragma unroll
    for (int k = 0; k < 4; ++k) if (bad[k]) atomicAdd((unsigned*)(p.ws + WS_DIFF) + k, bad[k]);
}
#endif
#if PROBE_HYENA
__device__ __forceinline__ void probe_hyena_compare(const Params& p, int bid, int nb) {
    const bf16_t* YH = (const bf16_t*)(p.ws + WS_YH);
    const bf16_t* ymix = (const bf16_t*)(p.ws + WS_YMIX);
    unsigned bad = 0;
    for (size_t i = (size_t)bid * NTHREADS + threadIdx.x; i < (size_t)512 * 65536; i += (size_t)nb * NTHREADS) {
        const int c = (int)(i >> 16), bt = (int)(i & 65535);
        const float a = bf2f(YH[i]), r = bf2f(ymix[(size_t)bt * 1024 + c]);
        if (!(fabsf(a - r) <= 0.016f * fabsf(r) + 0.004f)) ++bad;
    }
    if (bad) atomicAdd((unsigned*)(p.ws + WS_DIFF), bad);
}
#endif
__device__ __forceinline__ void h_local_sync() {
    asm volatile("s_waitcnt vmcnt(0)" ::: "memory");
    __builtin_amdgcn_fence(__ATOMIC_RELEASE, "workgroup");
    __syncthreads();
    __builtin_amdgcn_fence(__ATOMIC_ACQUIRE, "agent");
}
constexpr int N_PHASES = 10;
__global__ void __launch_bounds__(NTHREADS, 2) fwd_kernel(Params p) {
    const int bid = blockIdx.x, nb = gridDim.x;
    LAS unsigned* xbw = (LAS unsigned*)(g_lds + LDS_BYTES - 16);
    XcdBarrier bar; bar.bar = (unsigned*)(p.ws + WS_BAR); bar.x = 0; bar.st = (volatile LAS unsigned*)xbw;
    const bool multi = (p.ph_hi - p.ph_lo) > 1;
    if (multi) {
        if (threadIdx.x == 0) { xbw[0] = 0u; xbw[1] = 0u; xbw[2] = 0u; xbw[3] = 0u; }
        __syncthreads();
        bar = xcd_barrier_post((unsigned*)(p.ws + WS_BAR), (volatile LAS unsigned*)xbw);
    }
#ifndef REP_PHASE
#define REP_PHASE -1
#endif
#ifndef REP_COUNT
#define REP_COUNT 2
#endif
#define PHASE(i, call) if (p.ph_lo <= (i) && (i) < p.ph_hi) { for (int rep_ = 0; rep_ < ((i) == REP_PHASE ? REP_COUNT : 1); ++rep_) { call; __syncthreads(); } if ((i) + 1 < p.ph_hi) xcd_barrier(bar); }
    PHASE(0, phase_a(p, bid, nb))
    PHASE(1, (norm_rows<1>(p.x, T, p.norm1_g, (const float*)(p.ws + WS_MOD), 0, 1, nullptr, p.ws + WS_HX, BatchLat(), bid, nb),
              norm_rows<1>(p.ctx, TC, p.norm1_g, (const float*)(p.ws + WS_MOD), 0, 1, nullptr, p.ws + WS_HX + (size_t)T * 1024, BatchCtx(), bid, nb)))
    PHASE(2, phase_c(p, bid, nb))
#if PROBE_HYENA == 2
    PHASE(3, (phase_hgrn_mfma(p, bid, nb), phase_hyena_naive(p, bid, nb)))
#elif PROBE_HYENA
    PHASE(3, (phase_hgrn_mfma(p, bid, nb), phase_hyena_naive(p, bid, nb), phase_hyena_mfma(p, bid, nb)))
#elif PROBE_HGRN == 3
    PHASE(3, (phase_hgrn_naive(p, bid, nb, WS_O), phase_hyena_mfma(p, bid, nb)))
#elif PROBE_HGRN == 4 || PROBE_HGRN == 5 || PROBE_HGRN == 6 || PROBE_HGRN == 7
    PHASE(3, (phase_hgrn_naive(p, bid, nb, WS_O), phase_hgrn_mfma(p, bid, nb, WS_O2), phase_hyena_mfma(p, bid, nb)))
#elif PROBE_HGRN == 2
    PHASE(3, (phase_hgrn_mfma(p, bid, nb, WS_O2), probe_trash_lds(), phase_hgrn_mfma(p, bid, nb), phase_hyena_mfma(p, bid, nb)))
#elif PROBE_HGRN
    PHASE(3, (phase_hgrn_naive(p, bid, nb, WS_O2), phase_hgrn_mfma(p, bid, nb), phase_hyena_mfma(p, bid, nb)))
#elif defined(REP_D_HG)
    PHASE(3, (phase_hgrn_mfma(p, bid, nb), __syncthreads(), phase_hgrn_mfma(p, bid, nb), phase_hyena_mfma(p, bid, nb)))
#elif defined(REP_D_HY)
    PHASE(3, (phase_hgrn_mfma(p, bid, nb), phase_hyena_mfma(p, bid, nb), __syncthreads(), phase_hyena_mfma(p, bid, nb)))
#else
    PHASE(3, (phase_hgrn_mfma(p, bid, nb), phase_hyena_mfma(p, bid, nb)))
#endif
#if PROBE_HYENA == 1
    PHASE(4, (probe_hyena_compare(p, bid, nb), phase_e(p, bid, nb)))
#elif PROBE_HGRN == 1 || PROBE_HGRN == 2 || PROBE_HGRN == 5 || PROBE_HGRN == 6
    PHASE(4, (probe_hgrn_compare(p, bid, nb), phase_e(p, bid, nb)))
#else
    PHASE(4, phase_e(p, bid, nb))
#endif
    PHASE(5, phase_f(p, bid, nb))
    PHASE(6, (norm_rows<2>(p.out, T, p.norm2_g, (const float*)(p.ws + WS_MOD), 3, 4, (bf16_t*)(p.ws + WS_HX2), p.ws + WS_HX2F8, BatchLat(), bid, nb),
              h_local_sync(), phase_h(p, bid, nb)))
    PHASE(7, phase_i(p, bid, nb))
    PHASE(8, phase_j(p, bid, nb))
    PHASE(9, phase_k(p, bid, nb))
}

extern "C" void kernel_launch(void* const* d_in, const int* in_sizes, int n_in, void* d_out, int out_size, void* d_ws, size_t ws_size, hipStream_t stream) {
    static int grid = 0;
    if (grid == 0) {
        if (n_in != 30 || out_size != T * D || ws_size < WS_END) { fprintf(stderr, "kernel_launch: unexpected shapes (n_in %d out %d ws %zu need %zu)\n", n_in, out_size, ws_size, (size_t)WS_END); grid = -1; return; }
        int dev = 0, cus = 0, per_cu = 0;
        hipGetDevice(&dev); hipDeviceGetAttribute(&cus, hipDeviceAttributeMultiprocessorCount, dev);
        if (hipFuncSetAttribute((const void*)fwd_kernel, hipFuncAttributeMaxDynamicSharedMemorySize, LDS_BYTES) != hipSuccess) { fprintf(stderr, "kernel_launch: hipFuncSetAttribute failed\n"); grid = -1; return; }
        hipOccupancyMaxActiveBlocksPerMultiprocessor(&per_cu, (const void*)fwd_kernel, NTHREADS, LDS_BYTES);
        (void)hipGetLastError();
        if (per_cu < 1) fprintf(stderr, "kernel_launch: occupancy query says %d blocks per CU\n", per_cu);
        grid = cus > 0 ? cus : 256;
    }
    if (grid < 0) return;
    hipMemsetAsync((char*)d_ws, 0, WS_CTL_BYTES, stream);
    Params p{};
    const float** pp = (const float**)&p;
    for (int i = 0; i < 30; ++i) pp[i] = (const float*)d_in[i];
    p.out = (float*)d_out; p.ws = (unsigned char*)d_ws;
#if N_LAUNCH_SPLIT
    for (int i = 0; i < N_PHASES; ++i) { p.ph_lo = i; p.ph_hi = i + 1; hipLaunchKernelGGL(fwd_kernel, dim3(grid), dim3(NTHREADS), LDS_BYTES, stream, p); }
#else
    p.ph_lo = 0; p.ph_hi = N_PHASES;
    hipLaunchKernelGGL(fwd_kernel, dim3(grid), dim3(NTHREADS), LDS_BYTES, stream, p);
#endif
}
```
